# Optimizing an MI355X kernel written in HIP

```python
import math
import jax, jax.numpy as jnp
from jax import lax
import numpy as np

D_MODEL = 2048
BATCH = 2
SEQ = 8192
DEPTH = 4

GRID_W = 64
CTX_LEN = 256
N_MIXERS = 2
N_ATTN = (DEPTH + N_MIXERS - 1) // N_MIXERS
N_CONV = DEPTH // N_MIXERS
DIFF_HEADS = 8
HEAD_DIM = 128
V_HEAD_DIM = 2 * HEAD_DIM
QK_WIDTH = DIFF_HEADS * 2 * HEAD_DIM
V_WIDTH = DIFF_HEADS * V_HEAD_DIM
QKV_WIDTH = 2 * QK_WIDTH + V_WIDTH
ROPE_THETA = 10000.0
Q_BLOCK = 128
CONV_W = 3
D_FF = 5632
N_MOD = 6
EPS = 1e-6

kernel_name = "hybrid_diffattn_shortconv_dit_trunk"


def rmsnorm(x, gain=None):
    xf = x.astype(jnp.float32)
    y = (xf * lax.rsqrt(jnp.mean(xf * xf, axis=-1, keepdims=True) + EPS)).astype(x.dtype)
    return y if gain is None else y * gain


def adaln(cond, w_ada, b_ada):
    mod = jax.nn.silu(cond) @ w_ada + b_ada
    return jnp.split(mod, N_MOD, axis=-1)


def modulate(h, shift, scale):
    return h * (1.0 + scale) + shift


def dwconv3(x, w):
    xp = jnp.pad(x, ((0, 0), (1, 1), (0, 0)))
    return xp[:, :-2] * w[0] + xp[:, 1:-1] * w[1] + xp[:, 2:] * w[2]


def axial_rope_tables(n_tokens):
    rows = n_tokens // GRID_W
    row = jnp.repeat(jnp.arange(rows, dtype=jnp.float32), GRID_W)
    col = jnp.tile(jnp.arange(GRID_W, dtype=jnp.float32), rows)
    half = HEAD_DIM // 2
    inv_freq = 1.0 / (ROPE_THETA ** (jnp.arange(0, half, 2, dtype=jnp.float32) / half))
    ang_r = row[:, None] * inv_freq
    ang_c = col[:, None] * inv_freq
    return (jnp.cos(ang_r), jnp.sin(ang_r), jnp.cos(ang_c), jnp.sin(ang_c))


def _rot_half(x, cos, sin):
    x1, x2 = jnp.split(x, 2, axis=-1)
    return jnp.concatenate([x1 * cos - x2 * sin, x2 * cos + x1 * sin], axis=-1)


def apply_axial_rope(x, tables):
    cr, sr, cc, sc = [t[None, :, None, None, :].astype(x.dtype) for t in tables]
    xr, xcol = jnp.split(x, 2, axis=-1)
    return jnp.concatenate([_rot_half(xr, cr, sr), _rot_half(xcol, cc, sc)], axis=-1)


def diff_attn_core(q, k, v, lam):
    s = jnp.einsum('bqhid,bkhid->bhiqk', q, k) * (HEAD_DIM ** -0.5)
    p = jax.nn.softmax(s.astype(jnp.float32), axis=-1)
    a = p[:, :, 0] - lam * p[:, :, 1]
    return jnp.einsum('bhqk,bkhe->bqhe', a.astype(v.dtype), v)


def latent_diff_attn(q, k_all, v_all, lam):
    b, t = q.shape[0], q.shape[1]
    nb = t // Q_BLOCK
    qb = q.reshape(b, nb, Q_BLOCK, DIFF_HEADS, 2, HEAD_DIM).transpose(1, 0, 2, 3, 4, 5)
    out = lax.map(lambda qblk: diff_attn_core(qblk, k_all, v_all, lam), qb)
    return out.transpose(1, 0, 2, 3, 4).reshape(b, t, DIFF_HEADS, V_HEAD_DIM)


def diff_head_out(o, subln_gain, lam_init, w_o):
    o = rmsnorm(o, subln_gain) * (1.0 - lam_init)
    return o.reshape(o.shape[0], o.shape[1], V_WIDTH) @ w_o


def split_qk(y, t):
    b = y.shape[0]
    return y.reshape(b, t, DIFF_HEADS, 2, HEAD_DIM)


def diff_attn_mixer(hl, hc, w_qkv, w_o, lq1, lk1, lq2, lk2, subln_gain, lam_init, rope_tables, need_ctx_out):
    b, t = hl.shape[0], hl.shape[1]
    lc = hc.shape[1]
    lam = (jnp.exp(jnp.sum(lq1.astype(jnp.float32) * lk1.astype(jnp.float32)))
           - jnp.exp(jnp.sum(lq2.astype(jnp.float32) * lk2.astype(jnp.float32))) + lam_init)
    yl = hl @ w_qkv
    ql = apply_axial_rope(split_qk(yl[..., :QK_WIDTH], t), rope_tables)
    kl = apply_axial_rope(split_qk(yl[..., QK_WIDTH:2 * QK_WIDTH], t), rope_tables)
    vl = yl[..., 2 * QK_WIDTH:].reshape(b, t, DIFF_HEADS, V_HEAD_DIM)
    if need_ctx_out:
        yc = hc @ w_qkv
        qc = split_qk(yc[..., :QK_WIDTH], lc)
        kv_c = yc[..., QK_WIDTH:]
    else:
        kv_c = hc @ w_qkv[:, QK_WIDTH:]
    kc = split_qk(kv_c[..., :QK_WIDTH], lc)
    vc = kv_c[..., QK_WIDTH:].reshape(b, lc, DIFF_HEADS, V_HEAD_DIM)
    k_all = jnp.concatenate([kl, kc], axis=1)
    v_all = jnp.concatenate([vl, vc], axis=1)
    out_l = diff_head_out(latent_diff_attn(ql, k_all, v_all, lam), subln_gain, lam_init, w_o)
    out_c = None
    if need_ctx_out:
        out_c = diff_head_out(diff_attn_core(qc, kc, vc, lam), subln_gain, lam_init, w_o)
    return out_l, out_c


def short_conv_mixer(h, w_in, conv_w, w_out):
    y = h @ w_in
    gb, gc, xv = jnp.split(y, 3, axis=-1)
    return (gb * dwconv3(gc * xv, conv_w)) @ w_out


def conv_ffn(h, w_up, conv_w, w_down):
    u = dwconv3(h @ w_up, conv_w)
    g, v = jnp.split(u, 2, axis=-1)
    return (jax.nn.silu(g) * v) @ w_down


def setup_inputs(seed: int = 0) -> dict:
    key = jax.random.key(seed)
    ks = jax.random.split(key, 24)
    f32 = jnp.float32
    nrm = lambda k, shape, s: jax.random.normal(k, shape, f32) * s
    d = D_MODEL
    return {
        "x": nrm(ks[0], (BATCH, SEQ, d), 1.0),
        "c": nrm(ks[1], (BATCH, d), 1.0),
        "ctx": nrm(ks[2], (BATCH, CTX_LEN, d), 1.0),
        "c_ctx": nrm(ks[3], (d,), 1.0),
        "w_ada": nrm(ks[4], (DEPTH, d, N_MOD * d), 0.5 * d ** -0.5),
        "b_ada": nrm(ks[5], (DEPTH, N_MOD * d), 0.02),
        "attn_w_qkv": nrm(ks[6], (N_ATTN, d, QKV_WIDTH), d ** -0.5),
        "attn_w_o": nrm(ks[7], (N_ATTN, V_WIDTH, d), V_WIDTH ** -0.5),
        "attn_lambda_q1": nrm(ks[8], (N_ATTN, HEAD_DIM), 0.1),
        "attn_lambda_k1": nrm(ks[9], (N_ATTN, HEAD_DIM), 0.1),
        "attn_lambda_q2": nrm(ks[10], (N_ATTN, HEAD_DIM), 0.1),
        "attn_lambda_k2": nrm(ks[11], (N_ATTN, HEAD_DIM), 0.1),
        "attn_subln_gain": 1.0 + nrm(ks[12], (N_ATTN, V_HEAD_DIM), 0.02),
        "sconv_w_in": nrm(ks[13], (N_CONV, d, 3 * d), d ** -0.5),
        "sconv_conv": nrm(ks[14], (N_CONV, CONV_W, d), CONV_W ** -0.5),
        "sconv_w_out": nrm(ks[15], (N_CONV, d, d), d ** -0.5),
        "ffn_w_up": nrm(ks[16], (DEPTH, d, 2 * D_FF), d ** -0.5),
        "ffn_conv": nrm(ks[17], (DEPTH, CONV_W, 2 * D_FF), CONV_W ** -0.5),
        "ffn_w_down": nrm(ks[18], (DEPTH, D_FF, d), D_FF ** -0.5),
        "final_gain": 1.0 + nrm(ks[19], (d,), 0.02),
    }


def reference(x, c, ctx, c_ctx, w_ada, b_ada, attn_w_qkv, attn_w_o, attn_lambda_q1, attn_lambda_k1,
              attn_lambda_q2, attn_lambda_k2, attn_subln_gain, sconv_w_in, sconv_conv, sconv_w_out,
              ffn_w_up, ffn_conv, ffn_w_down, final_gain):
    n_tokens = x.shape[1]
    rope_tables = axial_rope_tables(n_tokens)
    last_attn = max(i for i in range(DEPTH) if i % N_MIXERS == 0)
    xl, xc = x, ctx
    for i in range(DEPTH):
        ctx_update = i < last_attn
        ctx_read = i <= last_attn and i % N_MIXERS == 0
        sh1, sc1, g1, sh2, sc2, g2 = [m[:, None, :] for m in adaln(c, w_ada[i], b_ada[i])]
        hl = modulate(rmsnorm(xl), sh1, sc1)
        if ctx_update or ctx_read:
            csh1, csc1, cg1, csh2, csc2, cg2 = adaln(c_ctx, w_ada[i], b_ada[i])
            hc = modulate(rmsnorm(xc), csh1, csc1)
        if i % N_MIXERS == 0:
            a = i // N_MIXERS
            lam_init = 0.8 - 0.6 * math.exp(-0.3 * i)
            yl, yc = diff_attn_mixer(hl, hc, attn_w_qkv[a], attn_w_o[a], attn_lambda_q1[a], attn_lambda_k1[a],
                                     attn_lambda_q2[a], attn_lambda_k2[a], attn_subln_gain[a], lam_init,
                                     rope_tables, ctx_update)
        else:
            j = i // N_MIXERS
            yl = short_conv_mixer(hl, sconv_w_in[j], sconv_conv[j], sconv_w_out[j])
            if ctx_update:
                yc = short_conv_mixer(hc, sconv_w_in[j], sconv_conv[j], sconv_w_out[j])
        xl = xl + g1 * yl
        xl = xl + g2 * conv_ffn(modulate(rmsnorm(xl), sh2, sc2), ffn_w_up[i], ffn_conv[i], ffn_w_down[i])
        if ctx_update:
            xc = xc + cg1 * yc
            xc = xc + cg2 * conv_ffn(modulate(rmsnorm(xc), csh2, csc2), ffn_w_up[i], ffn_conv[i], ffn_w_down[i])
    return rmsnorm(xl, final_gain)
```

```cpp
#include <hip/hip_runtime.h>
#include <hip/hip_bf16.h>
#include <cstdio>
#include <cstdint>

#ifndef MK_PER_PHASE
#define MK_PER_PHASE 0
#endif

constexpr int DM = 2048, NBATCH = 2, SEQ = 8192, CTXL = 256, DEPTH = 4;
constexpr int ROWS_B = SEQ + CTXL;
constexpr int R = NBATCH * ROWS_B;
constexpr int PAN_B = ROWS_B / 256;
constexpr int NPAN = R / 256;
constexpr int QKVW = 6144, DFF = 5632, UPW = 2 * DFF, NMODW = 6 * DM;
constexpr float EPS = 1e-6f;
constexpr int NWAVES = 8;

__constant__ float INV_FREQ[32] = {1.f, 0.749894202f, 0.562341332f, 0.421696514f, 0.316227764f, 0.237137392f, 0.177827939f, 0.133352146f, 0.100000001f, 0.0749894157f, 0.0562341288f,
    0.0421696492f, 0.0316227786f, 0.0237137359f, 0.0177827943f, 0.0133352149f, 0.00999999978f, 0.00749894232f, 0.00562341325f, 0.00421696482f, 0.00316227786f, 0.00237137382f, 0.00177827943f,
    0.00133352145f, 0.00100000005f, 0.000749894185f, 0.000562341302f, 0.000421696546f, 0.000316227786f, 0.000237137385f, 0.00017782794f, 0.00013335215f};

__device__ __forceinline__ int opaque_tid(int wid_s) { int t; asm volatile("v_mbcnt_lo_u32_b32 %0, -1, 0\n\tv_mbcnt_hi_u32_b32 %0, -1, %0" : "=v"(t)); return wid_s * 64 + t; }

template <int X> __device__ __forceinline__ float swz_xor(float v) { return __builtin_bit_cast(float, __builtin_amdgcn_ds_swizzle(__builtin_bit_cast(int, v), (X << 10) | 0x1f)); }
__device__ __forceinline__ float half_sum32(float v) { v += swz_xor<1>(v); v += swz_xor<2>(v); v += swz_xor<4>(v); v += swz_xor<8>(v); v += swz_xor<16>(v); return v; }

namespace pg8 {
#define PG8_LAS __attribute__((address_space(3)))
typedef unsigned short bf16_t;
typedef short bf16x8 __attribute__((ext_vector_type(8)));
typedef float f32x4 __attribute__((ext_vector_type(4)));
typedef float f32x2 __attribute__((ext_vector_type(2)));
typedef unsigned u32x4 __attribute__((ext_vector_type(4)));
constexpr int BM = 256, BK = 64, HALF = 128, HTB = HALF * BK * 2  , STAGE_BYTES = 8 * HTB, NXCD = 8;

__host__ __device__ __forceinline__ int lds_byte(int r, int c) { const int st = (r >> 4) * 2 + (c >> 5), rr = r & 15, cc = c & 31, ob = rr * 64 + cc * 2; return st * 1024 + (ob ^ (((ob >> 9) & 1) << 5)); }
__host__ __device__ __forceinline__ void stage_rc(int b, int& R_, int& C_) { const int st = b / 1024, sb = b % 1024, swz = sb ^ (((sb >> 9) & 1) << 5); R_ = (st >> 1) * 16 + swz / 64; C_ = (st & 1) * 32 + (swz % 64) / 2; }
__host__ __device__ __forceinline__ int perm32(int rho) { const int n = rho >> 4, i = rho & 15; return 8 * (i >> 2) + 4 * n + (i & 3); }

struct Unit { int pm, pn, k0, nt, kpart, swap, part, pnb; };
struct Gemm { const bf16_t* A; const bf16_t* Bt; int K; };

struct PanelOrder {
    int nM, nN, nwg, G, c, ktiles, cfg;
    __device__ __forceinline__ void init(int nM_, int nN_, int G_, int c_, int skip_, int ktiles_, int ksplit_ = 0, int wgm_ = 4, int vswap_ = 0) { nM = nM_; nN = nN_; nwg = nM * nN; G = G_; c = c_; ktiles = ktiles_; cfg = skip_ | (ksplit_ << 4) | (wgm_ << 8) | (vswap_ << 16); }
    __device__ __forceinline__ bool next(int i, Unit& u) const {
        const int skip = cfg & 15, ksplit = (cfg >> 4) & 15, WGM = (cfg >> 8) & 255, vswap = cfg >> 16;
        const long L = (long)i * G + c;
        if (L >= nwg) { const int sidx = (int)(L - nwg); if (sidx >= 2 * nN * ksplit) return false;
            const int ts = sidx / ksplit, kp = sidx % ksplit, per = ktiles / ksplit;
            u.pm = (ts < nN) ? 32 : 65; u.pn = (ts < nN) ? ts : ts - nN; u.k0 = kp * per; u.nt = per; u.kpart = kp; u.swap = (vswap && u.pn >= vswap) ? 1 : 0; u.part = 0; u.pnb = u.pn; return true; }
        int wgid = (int)L; { const int q = nwg / NXCD, r = nwg % NXCD, xcd = wgid % NXCD, off = wgid / NXCD; wgid = (xcd < r ? xcd * (q + 1) : r * (q + 1) + (xcd - r) * q) + off; }
        const int nig = WGM * nN, gid = wgid / nig, fm = gid * WGM, gsz = (nM - fm) < WGM ? (nM - fm) : WGM;
        int pm = fm + ((wgid % nig) % gsz); u.pn = (wgid % nig) / gsz;
        if (skip) pm += (pm >= 32) ? 1 : 0;
        u.pm = pm; u.k0 = 0; u.nt = ktiles; u.kpart = -1; u.swap = (vswap && u.pn >= vswap) ? 1 : 0; u.part = 0; u.pnb = u.pn; return true;
    }
    __device__ __forceinline__ void a_ready(const Unit&) const {}
    __device__ __forceinline__ void done(const Unit&) const {}
};

struct QkvOrder {
    int G, c;
    __device__ __forceinline__ static void map(int nN, int L, int& pm, int& pn) {
        const int nwg = 64 * nN; int wgid = L; { const int q = nwg / NXCD, xcd = wgid % NXCD, off = wgid / NXCD; wgid = xcd * q + off; }
        const int nig = 4 * nN; pm = (wgid / nig) * 4 + ((wgid % nig) & 3); pn = (wgid % nig) >> 2; pm += (pm >= 32) ? 1 : 0;
    }
    __device__ __forceinline__ bool next(int i, Unit& u) const {
        u.k0 = 0; u.nt = DM / 128; u.kpart = -1;
        const int nq = (1024 - c + G - 1) / G, nv = (512 - c + G - 1) / G;
        if (i < nq) { map(16, i * G + c, u.pm, u.pn); u.swap = 0; u.part = 0; u.pnb = u.pn; return true; }
        i -= nq;
        if (i < 2 * nv) { int pn; map(8, (i >> 1) * G + c, u.pm, pn); u.pn = 16 + pn; u.swap = 1; u.part = 1 + (i & 1); u.pnb = u.pn + ((i & 1) ? 8 : 0); return true; }
        i -= 2 * nv;
        for (int x = c; x < 48; x += G) {
            const int nu = (x < 32) ? 1 : 2;
            if (i < nu) { if (x < 32) { u.pm = (x < 16) ? 32 : 65; u.pn = x & 15; u.swap = 0; u.part = 0; u.pnb = u.pn; }
                          else { const int y = x - 32; u.pm = (y < 8) ? 32 : 65; u.pn = 16 + (y & 7); u.swap = 1; u.part = 1 + i; u.pnb = u.pn + (i ? 8 : 0); }
                          return true; }
            i -= nu; }
        return false;
    }
    __device__ __forceinline__ void a_ready(const Unit&) const {}
    __device__ __forceinline__ void done(const Unit&) const {}
};

__device__ __forceinline__ unsigned cvt_pk_bf16(float lo, float hi) { unsigned r; asm volatile("v_cvt_pk_bf16_f32 %0, %1, %2" : "=v"(r) : "v"(lo), "v"(hi)); return r; }

struct EpiStoreBf16 {
    static constexpr bool PERM = true, AFTER_DRAIN = false, SIMPLE_STORE = true;
    bf16_t* O; int ldc;
    __device__ __forceinline__ void operator()(const f32x4 (&acc)[2][2][4][2], const Unit& u, int wr, int wc, int fr, int fq) const {
        const int row0 = u.pm * BM + wr * 64 + fr; const int col0 = u.pn * BM + wc * 32 + 8 * fq;
#pragma unroll
        for (int ai = 0; ai < 2; ++ai)
#pragma unroll
            for (int m = 0; m < 4; ++m) { bf16_t* rowp = O + (size_t)(row0 + ai * HALF + m * 16) * ldc + col0;
#pragma unroll
                for (int bj = 0; bj < 2; ++bj) { const f32x4 v0 = acc[ai][bj][m][0], v1 = acc[ai][bj][m][1];
                    u32x4 w; w.x = cvt_pk_bf16(v0[0], v0[1]); w.y = cvt_pk_bf16(v0[2], v0[3]); w.z = cvt_pk_bf16(v1[0], v1[1]); w.w = cvt_pk_bf16(v1[2], v1[3]);
                    *(u32x4*)(rowp + bj * HALF) = w; } }
    }
};
__device__ __forceinline__ unsigned pk4_fp8(float a, float b, float c, float d) {
    int w = __builtin_amdgcn_cvt_pk_fp8_f32(a, b, 0, false); w = __builtin_amdgcn_cvt_pk_fp8_f32(c, d, w, true); return (unsigned)w; }
typedef unsigned u32x2 __attribute__((ext_vector_type(2)));
struct EpiQKV {
    static constexpr bool PERM = true, AFTER_DRAIN = false, SIMPLE_STORE = true;
    unsigned char* Q8; const float* rope; unsigned char* KT; unsigned char* VT; int wid0;
    __device__ __forceinline__ void operator()(const f32x4 (&acc)[2][2][4][2], const Unit& u, int wr_, int wc_, int fr_, int fq_) const {
        const int tid_ = opaque_tid(wid0), wid_ = __builtin_amdgcn_readfirstlane(tid_ >> 6), lane_ = tid_ & 63, wr = wid_ >> 2, wc = wid_ & 3, fr = lane_ & 15, fq = lane_ >> 4;
        (void)wr_; (void)wc_; (void)fr_; (void)fq_;
        const int pp = u.pm % PAN_B, bb = u.pm / PAN_B;
        if (u.swap) {
            const int hh_ = u.pn - 16;
#pragma unroll
            for (int ai = 0; ai < 2; ++ai)
#pragma unroll
                for (int m = 0; m < 4; ++m) { const int vc = ai * HALF + wr * 64 + m * 16 + fr, cb = vc >> 5, nn = vc & 31;
#pragma unroll
                    for (int bj = 0; bj < 2; ++bj) { const int jt = pp * 4 + 2 * bj + (wc >> 1), f = wc & 1;
                        unsigned char* img = VT + ((size_t)((bb * 8 + hh_) * 132 + jt) * 16384 + (size_t)(cb * 2048 + f * 1024 + 4 * fq));
                        const f32x4 v0 = acc[ai][bj][m][0], v1 = acc[ai][bj][m][1];
                        constexpr float IW = 1.f / 64.f;
                        *(unsigned*)(img + nn * 16) = pk4_fp8(v0[0] * IW, v0[1] * IW, v0[2] * IW, v0[3] * IW);
                        *(unsigned*)(img + (nn + 32) * 16) = pk4_fp8(v1[0] * IW, v1[1] * IW, v1[2] * IW, v1[3] * IW); } }
            return; }
        const bool do_rope = (pp != 32);
        const int t0 = pp * 256 + wr * 64 + fr; const int f0 = 16 * (wc & 1) + 4 * fq;
        const int cl = wc * 32 + 8 * fq;
#pragma unroll
        for (int ai = 0; ai < 2; ++ai)
#pragma unroll
            for (int m = 0; m < 4; ++m) { const int rowu = u.pm * BM + ai * HALF + wr * 64 + m * 16 + fr;
                const int jt = pp * 4 + 2 * ai + wr, kr = 16 * m + fr;
                f32x4 cs0 = (f32x4){1.f, 0.f, 1.f, 0.f}, cs1 = cs0;
                if (do_rope) { const int t = t0 + ai * HALF + m * 16; const int pos = (wc < 2) ? (t >> 6) : (t & 63);
                    const f32x4* cp = (const f32x4*)(rope + (size_t)(pos * 32 + f0) * 2); cs0 = cp[0]; cs1 = cp[1]; }
#pragma unroll
                for (int bj = 0; bj < 2; ++bj) { const f32x4 v0 = acc[ai][bj][m][0], v1 = acc[ai][bj][m][1];
                    const float a0 = v0[0] * cs0[0] - v0[1] * cs0[1], a1 = v0[1] * cs0[0] + v0[0] * cs0[1];
                    const float a2 = v0[2] * cs0[2] - v0[3] * cs0[3], a3 = v0[3] * cs0[2] + v0[2] * cs0[3];
                    const float b0 = v1[0] * cs1[0] - v1[1] * cs1[1], b1 = v1[1] * cs1[0] + v1[0] * cs1[1];
                    const float b2 = v1[2] * cs1[2] - v1[3] * cs1[3], b3 = v1[3] * cs1[2] + v1[2] * cs1[3];
                    constexpr float SQC = 0.3570958286295132f / 64.f;
                    u32x2 w; w.x = pk4_fp8(a0 * SQC, a1 * SQC, a2 * SQC, a3 * SQC); w.y = pk4_fp8(b0 * SQC, b1 * SQC, b2 * SQC, b3 * SQC);
                    unsigned char* dst;
                    if (u.pn < 8) dst = Q8 + (size_t)rowu * DM + u.pn * BM + bj * HALF + cl;
                    else { const int hs = (u.pn - 8) * 2 + bj;
                        dst = KT + ((size_t)((bb * 16 + hs) * 132 + jt) * 8192 + (size_t)((((kr >> 5) * 2 + (cl >> 6)) * 2 + ((cl >> 4) & 1)) * 1024 + ((kr & 31) + 32 * ((cl >> 5) & 1)) * 16 + (cl & 15))); }
                    *(u32x2*)dst = w; } }
    }
};
struct EpiResidual {
    static constexpr bool PERM = false, AFTER_DRAIN = false, SIMPLE_STORE = false;
    float* X; const float* gate3; int gstride; const float* xin; const float* cin; float* slab; const float* zeros;
    __device__ __forceinline__ void operator()(const f32x4 (&acc)[2][2][4][2], const Unit& u, int wr, int wc, int fr, int fq) const {
        const int pp = u.pm % PAN_B, bb = u.pm / PAN_B; const int set = (pp == 32) ? 2 : bb;
        const float* g = gate3 + (size_t)set * gstride;
        const int col0 = u.pn * BM + wc * 32 + 4 * fq;
        f32x4 gv[2][2];
#pragma unroll
        for (int bj = 0; bj < 2; ++bj)
#pragma unroll
            for (int n = 0; n < 2; ++n) gv[bj][n] = *(const f32x4*)(g + col0 + bj * HALF + n * 16);
        const bool part = u.kpart >= 0;
        float* dstb = part ? slab + ((size_t)u.kpart * 512 + (size_t)bb * 256) * DM : X + (size_t)u.pm * BM * DM;
        const float* srcb = part ? zeros : (xin ? ((pp == 32) ? cin + (size_t)bb * CTXL * DM : xin + (size_t)(bb * SEQ + pp * 256) * DM) : X + (size_t)u.pm * BM * DM);
        const size_t sstr = part ? 0 : DM;
#pragma unroll
        for (int ai = 0; ai < 2; ++ai)
#pragma unroll
            for (int m = 0; m < 4; ++m) { const int rr = ai * HALF + wr * 64 + m * 16 + fr; float* rowp = dstb + (size_t)rr * DM + col0; const float* rowb = srcb + (size_t)rr * sstr + col0;
#pragma unroll
                for (int bj = 0; bj < 2; ++bj)
#pragma unroll
                    for (int n = 0; n < 2; ++n) { const f32x4 x = *(const f32x4*)(rowb + bj * HALF + n * 16); *(f32x4*)(rowp + bj * HALF + n * 16) = x + gv[bj][n] * acc[ai][bj][m][n]; }
                if (m & 1) asm volatile("" ::: "memory"); }
    }
};
__device__ __forceinline__ float dpp_ror1(float v) { return __builtin_bit_cast(float, __builtin_amdgcn_update_dpp(__builtin_bit_cast(int, v), __builtin_bit_cast(int, v), 0x121, 0xf, 0xf, true)); }
__device__ __forceinline__ float dpp_rol1(float v) { return __builtin_bit_cast(float, __builtin_amdgcn_update_dpp(__builtin_bit_cast(int, v), __builtin_bit_cast(int, v), 0x12F, 0xf, 0xf, true)); }
__device__ __forceinline__ float shr1_or(float v, float o) { return __builtin_bit_cast(float, __builtin_amdgcn_update_dpp(__builtin_bit_cast(int, o), __builtin_bit_cast(int, v), 0x111, 0xf, 0xf, false)); }
__device__ __forceinline__ float shl1_or(float v, float o) { return __builtin_bit_cast(float, __builtin_amdgcn_update_dpp(__builtin_bit_cast(int, o), __builtin_bit_cast(int, v), 0x101, 0xf, 0xf, false)); }
struct EpiConvGate {
    static constexpr bool PERM = true, AFTER_DRAIN = false, SIMPLE_STORE = false;
    bf16_t* ACT; float* YE; const float* cw; PG8_LAS float* E;
    __device__ __forceinline__ void operator()(const f32x4 (&acc)[2][2][4][2], const Unit& u, int wr, int wc, int fr, int fq) const {
        const int cb = wc * 32 + 8 * fq;
        const bool is0 = (fr == 0), is15 = (fr == 15);
#pragma unroll
        for (int ai = 0; ai < 2; ++ai) { const int q = 2 * ai + wr;
#pragma unroll
            for (int bj = 0; bj < 2; ++bj)
#pragma unroll
                for (int n = 0; n < 2; ++n) {
                    if (is0) *(PG8_LAS f32x4*)(E + (q * 2 + 0) * 256 + bj * 128 + cb + 4 * n) = acc[ai][bj][0][n];
                    if (is15) *(PG8_LAS f32x4*)(E + (q * 2 + 1) * 256 + bj * 128 + cb + 4 * n) = acc[ai][bj][3][n]; } }
        f32x4 w[3][2][2];
#pragma unroll
        for (int j = 0; j < 3; ++j)
#pragma unroll
            for (int bj = 0; bj < 2; ++bj)
#pragma unroll
                for (int n = 0; n < 2; ++n) w[j][bj][n] = *(const f32x4*)(cw + (size_t)j * UPW + bj * DFF + u.pn * 128 + cb + 4 * n);
        {   float* ye = YE + (size_t)u.pm * 4 * UPW + u.pn * 256 + cb;
            if (wr == 0 && fr < 2) {
#pragma unroll
                for (int bj = 0; bj < 2; ++bj)
#pragma unroll
                    for (int n = 0; n < 2; ++n) *(f32x4*)(ye + (size_t)fr * UPW + bj * 128 + 4 * n) = acc[0][bj][0][n]; }
            if (wr == 1 && fr >= 14) {
#pragma unroll
                for (int bj = 0; bj < 2; ++bj)
#pragma unroll
                    for (int n = 0; n < 2; ++n) *(f32x4*)(ye + (size_t)(fr - 12) * UPW + bj * 128 + 4 * n) = acc[1][bj][3][n]; } }
        asm volatile("s_waitcnt lgkmcnt(0)\n\ts_barrier" ::: "memory");
#pragma unroll
        for (int ai = 0; ai < 2; ++ai) { const int q = 2 * ai + wr;
            f32x4 ep[2][2], en[2][2];
#pragma unroll
            for (int bj = 0; bj < 2; ++bj)
#pragma unroll
                for (int n = 0; n < 2; ++n) { ep[bj][n] = (f32x4){0.f, 0.f, 0.f, 0.f}; en[bj][n] = ep[bj][n];
                    if (is0 && q > 0) ep[bj][n] = *(const PG8_LAS f32x4*)(E + ((q - 1) * 2 + 1) * 256 + bj * 128 + cb + 4 * n);
                    if (is15 && q < 3) en[bj][n] = *(const PG8_LAS f32x4*)(E + ((q + 1) * 2 + 0) * 256 + bj * 128 + cb + 4 * n); }
#pragma unroll
            for (int m = 0; m < 4; ++m) { u32x4 ow;
#pragma unroll
                for (int n = 0; n < 2; ++n) { f32x4 cv[2];
#pragma unroll
                    for (int bj = 0; bj < 2; ++bj) { const f32x4 cur = acc[ai][bj][m][n];
                        f32x4 pv, nx;
#pragma unroll
                        for (int e = 0; e < 4; ++e) {
                            pv[e] = shr1_or(cur[e], (m == 0) ? ep[bj][n][e] : dpp_ror1(acc[ai][bj][m > 0 ? m - 1 : 0][n][e]));
                            nx[e] = shl1_or(cur[e], (m == 3) ? en[bj][n][e] : dpp_rol1(acc[ai][bj][m < 3 ? m + 1 : 3][n][e])); }
                        cv[bj] = w[0][bj][n] * pv + w[1][bj][n] * cur + w[2][bj][n] * nx; }
                    float a[4];
#pragma unroll
                    for (int e = 0; e < 4; ++e) { const float g = cv[0][e]; a[e] = g * __builtin_amdgcn_rcpf(1.f + __builtin_amdgcn_exp2f(-1.4426950408889634f * g)) * cv[1][e]; }
                    ow[2 * n] = cvt_pk_bf16(a[0], a[1]); ow[2 * n + 1] = cvt_pk_bf16(a[2], a[3]); }
                const bool skip = (q == 0 && m == 0 && is0) || (q == 3 && m == 3 && is15);
                if (!skip) *(u32x4*)(ACT + (size_t)(u.pm * BM + ai * HALF + wr * 64 + m * 16 + fr) * DFF + u.pn * 128 + cb) = ow; } }
    }
};

struct EpiSconv {
    static constexpr bool PERM = true, AFTER_DRAIN = false, SIMPLE_STORE = false;
    bf16_t* GB; bf16_t* CZ; float* PE; const float* cw; PG8_LAS float* E;
    __device__ __forceinline__ void operator()(const f32x4 (&acc)[2][2][4][2], const Unit& u, int wr, int wc, int fr, int fq) const {
        const int cb = wc * 32 + 8 * fq;
        if (u.pn >= 16) {
            const int row0 = u.pm * BM + wr * 64 + fr; const int col0 = (u.pn - 16) * BM + cb;
#pragma unroll
            for (int ai = 0; ai < 2; ++ai)
#pragma unroll
                for (int m = 0; m < 4; ++m) { bf16_t* rowp = GB + (size_t)(row0 + ai * HALF + m * 16) * DM + col0;
#pragma unroll
                    for (int bj = 0; bj < 2; ++bj) { const f32x4 v0 = acc[ai][bj][m][0], v1 = acc[ai][bj][m][1];
                        u32x4 w; w.x = cvt_pk_bf16(v0[0], v0[1]); w.y = cvt_pk_bf16(v0[2], v0[3]); w.z = cvt_pk_bf16(v1[0], v1[1]); w.w = cvt_pk_bf16(v1[2], v1[3]);
                        *(u32x4*)(rowp + bj * HALF) = w; } }
            return; }
        const bool is0 = (fr == 0), is15 = (fr == 15);
        f32x4 p[2][4][2];
#pragma unroll
        for (int ai = 0; ai < 2; ++ai)
#pragma unroll
            for (int m = 0; m < 4; ++m)
#pragma unroll
                for (int n = 0; n < 2; ++n) p[ai][m][n] = acc[ai][0][m][n] * acc[ai][1][m][n];
#pragma unroll
        for (int ai = 0; ai < 2; ++ai) { const int q = 2 * ai + wr;
#pragma unroll
            for (int n = 0; n < 2; ++n) {
                if (is0) *(PG8_LAS f32x4*)(E + (q * 2 + 0) * 128 + cb + 4 * n) = p[ai][0][n];
                if (is15) *(PG8_LAS f32x4*)(E + (q * 2 + 1) * 128 + cb + 4 * n) = p[ai][3][n]; } }
        f32x4 w[3][2];
#pragma unroll
        for (int j = 0; j < 3; ++j)
#pragma unroll
            for (int n = 0; n < 2; ++n) w[j][n] = *(const f32x4*)(cw + (size_t)j * DM + u.pn * 128 + cb + 4 * n);
        {   float* pe = PE + (size_t)u.pm * 4 * DM + u.pn * 128 + cb;
            if (wr == 0 && fr < 2) {
#pragma unroll
                for (int n = 0; n < 2; ++n) *(f32x4*)(pe + (size_t)fr * DM + 4 * n) = p[0][0][n]; }
            if (wr == 1 && fr >= 14) {
#pragma unroll
                for (int n = 0; n < 2; ++n) *(f32x4*)(pe + (size_t)(fr - 12) * DM + 4 * n) = p[1][3][n]; } }
        asm volatile("s_waitcnt lgkmcnt(0)\n\ts_barrier" ::: "memory");
#pragma unroll
        for (int ai = 0; ai < 2; ++ai) { const int q = 2 * ai + wr;
            f32x4 ep[2], en[2];
#pragma unroll
            for (int n = 0; n < 2; ++n) { ep[n] = (f32x4){0.f, 0.f, 0.f, 0.f}; en[n] = ep[n];
                if (is0 && q > 0) ep[n] = *(const PG8_LAS f32x4*)(E + ((q - 1) * 2 + 1) * 128 + cb + 4 * n);
                if (is15 && q < 3) en[n] = *(const PG8_LAS f32x4*)(E + ((q + 1) * 2 + 0) * 128 + cb + 4 * n); }
#pragma unroll
            for (int m = 0; m < 4; ++m) { u32x4 ow;
#pragma unroll
                for (int n = 0; n < 2; ++n) { const f32x4 cur = p[ai][m][n];
                    f32x4 pv, nx;
#pragma unroll
                    for (int e = 0; e < 4; ++e) {
                        pv[e] = shr1_or(cur[e], (m == 0) ? ep[n][e] : dpp_ror1(p[ai][m > 0 ? m - 1 : 0][n][e]));
                        nx[e] = shl1_or(cur[e], (m == 3) ? en[n][e] : dpp_rol1(p[ai][m < 3 ? m + 1 : 3][n][e])); }
                    const f32x4 c = w[0][n] * pv + w[1][n] * cur + w[2][n] * nx;
                    ow[2 * n] = cvt_pk_bf16(c[0], c[1]); ow[2 * n + 1] = cvt_pk_bf16(c[2], c[3]); }
                const bool skip = (q == 0 && m == 0 && is0) || (q == 3 && m == 3 && is15);
                if (!skip) *(u32x4*)(CZ + (size_t)(u.pm * BM + ai * HALF + wr * 64 + m * 16 + fr) * DM + u.pn * 128 + cb) = ow; } }
    }
};

template <class Epi, class Sched, bool ALIGN_EPI = false, bool SP2 = false, bool FP8 = false>
__device__ __forceinline__ void gemm_phase(PG8_LAS unsigned char* lds, const Gemm g, const Sched& S, const Epi& E, int wid0) {
#ifdef NO_GEMM
    return;
#endif
    const int tid = opaque_tid(wid0), wid = __builtin_amdgcn_readfirstlane(tid >> 6), lane = tid & 63, wr = wid >> 2, wc = wid & 3, fr = lane & 15, fq = lane >> 4;
    const int K = g.K; int nt; constexpr int ES = FP8 ? 1 : 2;
    unsigned voffA, voffB;
    { int R_, C_; stage_rc(tid * 16, R_, C_); const int Rb = Epi::PERM ? ((R_ & ~31) + perm32(R_ & 31)) : R_;
        voffA = (unsigned)(R_ * K * ES + C_ * 2); voffB = (unsigned)(Rb * K * ES + C_ * 2); }
    const size_t rstep64 = (size_t)64 * K * ES;
    const size_t kstep = (size_t)(BK * 2);
    const size_t hstep = (size_t)HALF * K * ES;
    const size_t tstep = 2 * hstep;
    const unsigned ldsw = (unsigned)wid * 1024u;
    const int aoff = lds_byte(wr * 64 + fr, fq * 8), boff = lds_byte(wc * 32 + fr, fq * 8);
#define PG8_SA(b, h) (((b) * 2 + (h)) * HTB)
#define PG8_SB(b, h) ((4 + (b) * 2 + (h)) * HTB)
#define PG8_STAGE(bufoff, gbase, voff) do { _Pragma("unroll") for (int _i = 0; _i < 2; ++_i) \
        __builtin_amdgcn_global_load_lds((const unsigned*)(((const char*)(gbase) + _i * rstep64) + (voff)), (PG8_LAS unsigned*)(lds + (bufoff) + ldsw + _i * 8192), 16, 0, 0); } while (0)
#define PG8_LDA(dst, b, h) do { if constexpr (FP8) { _Pragma("unroll") for (int m = 0; m < 4; ++m) { dst##8[m].lo = *(const PG8_LAS v4i_*)(lds + PG8_SA(b, h) + aoff + m * 2048); dst##8[m].hi = *(const PG8_LAS v4i_*)(lds + PG8_SA(b, h) + aoff + m * 2048 + 1024); } } \
        else { _Pragma("unroll") for (int m = 0; m < 4; ++m) _Pragma("unroll") for (int k = 0; k < 2; ++k) dst[m][k] = *(const PG8_LAS bf16x8*)(lds + PG8_SA(b, h) + aoff + m * 2048 + k * 1024); } } while (0)
#define PG8_LDB(dst, b, h) do { if constexpr (FP8) { _Pragma("unroll") for (int n = 0; n < 2; ++n) { dst##8[n].lo = *(const PG8_LAS v4i_*)(lds + PG8_SB(b, h) + boff + n * 2048); dst##8[n].hi = *(const PG8_LAS v4i_*)(lds + PG8_SB(b, h) + boff + n * 2048 + 1024); } } \
        else { _Pragma("unroll") for (int n = 0; n < 2; ++n) _Pragma("unroll") for (int k = 0; k < 2; ++k) dst[n][k] = *(const PG8_LAS bf16x8*)(lds + PG8_SB(b, h) + boff + n * 2048 + k * 1024); } } while (0)
#define PG8_MMA(ai, bj, At, Bt) do { __builtin_amdgcn_s_setprio(1); \
        if constexpr (FP8) { _Pragma("unroll") for (int m = 0; m < 4; ++m) _Pragma("unroll") for (int n = 0; n < 2; ++n) \
                acc[ai][bj][m][n] = __builtin_amdgcn_mfma_scale_f32_16x16x128_f8f6f4(Bt##8[n], At##8[m], acc[ai][bj][m][n], 0, 0, 0, 0, 0, 0); } \
        else { _Pragma("unroll") for (int m = 0; m < 4; ++m) _Pragma("unroll") for (int n = 0; n < 2; ++n) _Pragma("unroll") for (int k = 0; k < 2; ++k) \
            acc[ai][bj][m][n] = __builtin_amdgcn_mfma_f32_16x16x32_bf16(Bt[n][k], At[m][k], acc[ai][bj][m][n], 0, 0, 0); } \
        __builtin_amdgcn_s_setprio(0); } while (0)
#define PG8_WAIT_V(n) asm volatile("s_waitcnt vmcnt(" #n ")" ::: "memory")
#define PG8_WAIT_L(n) asm volatile("s_waitcnt lgkmcnt(" #n ")" ::: "memory")
#define PG8_BAR __builtin_amdgcn_s_barrier()
#define PG8_SCHED __builtin_amdgcn_sched_barrier(0)
    Unit cur, nxt; int ui = 0;
    if (!S.next(0, cur)) return;
    f32x4 acc[2][2][4][2];
#pragma unroll
    for (int a = 0; a < 2; ++a)
#pragma unroll
        for (int b = 0; b < 2; ++b)
#pragma unroll
            for (int m = 0; m < 4; ++m)
#pragma unroll
                for (int n = 0; n < 2; ++n) acc[a][b][m][n] = (f32x4){0.f, 0.f, 0.f, 0.f};
    bf16x8 At[4][2], B0[2][2], B1[2][2];
    typedef int v8i_ __attribute__((ext_vector_type(8))); typedef int v4i_ __attribute__((ext_vector_type(4)));
    v8i_ At8[4], B08[2], B18[2];
    const char* cA = (cur.swap ? (const char*)g.Bt + (size_t)cur.pnb * tstep : (const char*)g.A + (size_t)cur.pm * tstep) + (size_t)cur.k0 * kstep;
    const char* cB = (cur.swap ? (const char*)g.A + (size_t)cur.pm * tstep : (const char*)g.Bt + (size_t)cur.pnb * tstep) + (size_t)cur.k0 * kstep;
    nt = cur.nt;
    S.a_ready(cur);
    if constexpr (SP2) {
        PG8_STAGE(PG8_SB(0, 0), cB, voffB); PG8_STAGE(PG8_SB(0, 1), cB + hstep, voffB); PG8_STAGE(PG8_SA(0, 0), cA, voffA); PG8_STAGE(PG8_SA(0, 1), cA + hstep, voffA);
        if (wr == 1) PG8_BAR;
        PG8_WAIT_V(2); PG8_BAR;
        PG8_STAGE(PG8_SB(1, 0), cB + kstep, voffB); PG8_STAGE(PG8_SA(1, 0), cA + kstep, voffA); PG8_STAGE(PG8_SB(1, 1), cB + hstep + kstep, voffB);
        PG8_WAIT_V(6); PG8_BAR;
    } else {
        PG8_STAGE(PG8_SB(0, 0), cB, voffB); PG8_STAGE(PG8_SA(0, 0), cA, voffA); PG8_STAGE(PG8_SB(0, 1), cB + hstep, voffB); PG8_STAGE(PG8_SA(0, 1), cA + hstep, voffA);
        if (wr == 1) PG8_BAR;
        PG8_WAIT_V(4); PG8_BAR;
        PG8_STAGE(PG8_SB(1, 0), cB + kstep, voffB); PG8_STAGE(PG8_SA(1, 0), cA + kstep, voffA); PG8_STAGE(PG8_SB(1, 1), cB + hstep + kstep, voffB);
        PG8_WAIT_V(6); PG8_BAR;
    }
    for (;;) {
        const bool has_next = S.next(ui + 1, nxt);
        const char* nA = has_next ? (nxt.swap ? (const char*)g.Bt + (size_t)nxt.pnb * tstep : (const char*)g.A + (size_t)nxt.pm * tstep) + (size_t)nxt.k0 * kstep : cA;
        const char* nB = has_next ? (nxt.swap ? (const char*)g.A + (size_t)nxt.pm * tstep : (const char*)g.Bt + (size_t)nxt.pnb * tstep) + (size_t)nxt.k0 * kstep : cB;
        for (int t = 0; t < nt; t += 2) {
            const bool last = (t == nt - 2);
            const char* a1 = cA + (size_t)(t + 1) * kstep;
            const char* a2 = last ? nA : cA + (size_t)(t + 2) * kstep; const char* b2 = last ? nB : cB + (size_t)(t + 2) * kstep;
            const char* a3 = a2 + kstep; const char* b3 = b2 + kstep;
            if (last && has_next) S.a_ready(nxt);
            if constexpr (SP2) {
            PG8_LDB(B0, 0, 0); PG8_LDB(B1, 0, 1); PG8_SCHED; PG8_LDA(At, 0, 0); PG8_STAGE(PG8_SA(1, 1), a1 + hstep, voffA);
            PG8_WAIT_V(8); PG8_WAIT_L(0); PG8_BAR; PG8_MMA(0, 0, At, B0); PG8_MMA(0, 1, At, B1); PG8_BAR; PG8_SCHED;
            PG8_LDA(At, 0, 1); PG8_STAGE(PG8_SB(0, 0), b2, voffB); PG8_STAGE(PG8_SB(0, 1), b2 + hstep, voffB); PG8_STAGE(PG8_SA(0, 0), a2, voffA);
            PG8_WAIT_V(8); PG8_WAIT_L(0); PG8_BAR; PG8_MMA(1, 0, At, B0); PG8_MMA(1, 1, At, B1); PG8_BAR; PG8_SCHED;
            PG8_LDB(B0, 1, 0); PG8_LDB(B1, 1, 1); PG8_SCHED; PG8_LDA(At, 1, 0); PG8_STAGE(PG8_SA(0, 1), a2 + hstep, voffA);
            PG8_WAIT_V(8); PG8_WAIT_L(0); PG8_BAR; PG8_MMA(0, 0, At, B0); PG8_MMA(0, 1, At, B1); PG8_BAR; PG8_SCHED;
            PG8_LDA(At, 1, 1); PG8_STAGE(PG8_SB(1, 0), b3, voffB); PG8_STAGE(PG8_SB(1, 1), b3 + hstep, voffB); PG8_STAGE(PG8_SA(1, 0), a3, voffA);
            PG8_WAIT_V(8); PG8_WAIT_L(0); PG8_BAR; PG8_MMA(1, 0, At, B0); PG8_MMA(1, 1, At, B1); PG8_BAR; PG8_SCHED;
            } else {
            PG8_LDB(B0, 0, 0); PG8_SCHED; PG8_LDA(At, 0, 0); PG8_STAGE(PG8_SA(1, 1), a1 + hstep, voffA);
            PG8_WAIT_L(8); PG8_BAR; PG8_WAIT_L(0); PG8_MMA(0, 0, At, B0); PG8_BAR; PG8_SCHED;
            PG8_LDB(B1, 0, 1); PG8_STAGE(PG8_SB(0, 0), b2, voffB);
            PG8_BAR; PG8_WAIT_L(0); PG8_MMA(0, 1, At, B1); PG8_BAR;
            PG8_LDA(At, 0, 1); PG8_STAGE(PG8_SA(0, 0), a2, voffA);
            PG8_BAR; PG8_WAIT_L(0); PG8_MMA(1, 0, At, B0); PG8_BAR; PG8_SCHED;
            PG8_STAGE(PG8_SB(0, 1), b2 + hstep, voffB);
            PG8_WAIT_V(6); PG8_BAR; PG8_MMA(1, 1, At, B1); PG8_BAR;
            PG8_LDB(B0, 1, 0); PG8_SCHED; PG8_LDA(At, 1, 0); PG8_STAGE(PG8_SA(0, 1), a2 + hstep, voffA);
            PG8_WAIT_L(8); PG8_BAR; PG8_WAIT_L(0); PG8_MMA(0, 0, At, B0); PG8_BAR; PG8_SCHED;
            PG8_LDB(B1, 1, 1); PG8_STAGE(PG8_SB(1, 0), b3, voffB);
            PG8_BAR; PG8_WAIT_L(0); PG8_MMA(0, 1, At, B1); PG8_BAR;
            PG8_LDA(At, 1, 1); PG8_STAGE(PG8_SA(1, 0), a3, voffA);
            PG8_BAR; PG8_WAIT_L(0); PG8_MMA(1, 0, At, B0); PG8_BAR; PG8_SCHED;
            PG8_STAGE(PG8_SB(1, 1), b3 + hstep, voffB);
            PG8_WAIT_V(6); PG8_BAR; PG8_MMA(1, 1, At, B1); PG8_BAR;
            }
        }
        if constexpr (ALIGN_EPI) { if (wr == 0) PG8_BAR; }
        if constexpr (!Epi::AFTER_DRAIN) { if (cur.part != 1) E(acc, cur, wr, wc, fr, fq);
            S.done(cur); }
        if (!has_next) break;
        if (nxt.part != 2)
#pragma unroll
        for (int a = 0; a < 2; ++a)
#pragma unroll
            for (int b = 0; b < 2; ++b)
#pragma unroll
                for (int m = 0; m < 4; ++m)
#pragma unroll
                    for (int n = 0; n < 2; ++n) acc[a][b][m][n] = (f32x4){0.f, 0.f, 0.f, 0.f};
        cur = nxt; cA = nA; cB = nB; ++ui; nt = cur.nt;
        if constexpr (ALIGN_EPI) { if (wr == 1) PG8_BAR; }
    }
    PG8_WAIT_V(0);
    if constexpr (!ALIGN_EPI) { if (wr == 0) PG8_BAR; }
    PG8_BAR;
#undef PG8_SA
#undef PG8_SB
#undef PG8_STAGE
#undef PG8_LDA
#undef PG8_LDB
#undef PG8_MMA
#undef PG8_WAIT_V
#undef PG8_WAIT_L
#undef PG8_BAR
#undef PG8_SCHED
}
}

namespace att {
using bf16 = __hip_bfloat16;
constexpr int D = 128, NW = 8, QBLK = 32, KVBLK = 64;
constexpr float SCALE = 0.088388347648318440f;
constexpr float THR = 8.f;
constexpr int LDQ = QKVW, LDK = QKVW, LDO = 2048;
constexpr size_t SHM_V = KVBLK * D * 2, SHM_K = KVBLK * D * 2, SHM_ATTN = 2 * SHM_V + 2 * SHM_K + NW * 64 * 4;
using bf16x8 = __attribute__((ext_vector_type(8))) short;
using s16x4  = __attribute__((ext_vector_type(4))) short;
using f32x16 = __attribute__((ext_vector_type(16))) float;
using u32x4  = __attribute__((ext_vector_type(4))) unsigned;
#define KSWZ(row, colB) ((row) * 256 + ((colB) ^ (((row) & 7) << 4)))
#define SBAR() __builtin_amdgcn_sched_barrier(0)
__device__ __forceinline__ int crow(int r, int hi) { return (r & 3) + 8 * (r >> 2) + 4 * hi; }
__device__ __forceinline__ unsigned cvtpk(float lo, float hi) { unsigned r; asm volatile("v_cvt_pk_bf16_f32 %0, %1, %2" : "=v"(r) : "v"(lo), "v"(hi)); return r; }
__device__ __forceinline__ bf16x8 ld8(const bf16* p) { return *reinterpret_cast<const bf16x8*>(p); }

__device__ __forceinline__ void partialSM(f32x16& p0, f32x16& p1, float& m_reg, float& mn, float& alpha) {
  constexpr float C = SCALE * 1.4426950408889634f;
  float pmax = p0[0];
#pragma unroll
  for (int r = 1; r < 16; ++r) pmax = fmaxf(pmax, p0[r]);
#pragma unroll
  for (int r = 0; r < 16; ++r) pmax = fmaxf(pmax, p1[r]);
  { auto rr = __builtin_amdgcn_permlane32_swap(__float_as_uint(pmax), __float_as_uint(pmax), false, false);
    pmax = fmaxf(__uint_as_float(rr[0]), __uint_as_float(rr[1])); }
  if (__builtin_expect(__all(pmax - m_reg <= THR / SCALE), 1)) { mn = m_reg; alpha = 1.f; }
  else { mn = fmaxf(m_reg, pmax); alpha = __builtin_amdgcn_exp2f((m_reg - mn) * C); m_reg = mn; }
  float mnC = -mn * C;
#pragma unroll
  for (int r = 0; r < 16; ++r) p0[r] = fmaf(p0[r], C, mnC);
#pragma unroll
  for (int r = 0; r < 16; ++r) p1[r] = fmaf(p1[r], C, mnC);
#pragma unroll
  for (int r = 0; r < 16; ++r) p0[r] = __builtin_amdgcn_exp2f(p0[r]);
}
__device__ __forceinline__ void finishSM(f32x16& p0, f32x16& p1, float alpha, float& l_reg, bf16x8& pa0, bf16x8& pa1, bf16x8& pa2, bf16x8& pa3) {
#pragma unroll
  for (int r = 0; r < 16; ++r) p1[r] = __builtin_amdgcn_exp2f(p1[r]);
  float ps = 0;
#pragma unroll
  for (int r = 0; r < 16; ++r) ps += p0[r];
#pragma unroll
  for (int r = 0; r < 16; ++r) ps += p1[r];
  { auto rr = __builtin_amdgcn_permlane32_swap(__float_as_uint(ps), __float_as_uint(ps), false, false);
    ps = __uint_as_float(rr[0]) + __uint_as_float(rr[1]); }
  l_reg = l_reg * alpha + ps;
#define PK4(P, BASE, OUT) do { unsigned a0 = cvtpk(P[BASE + 0], P[BASE + 1]), a1 = cvtpk(P[BASE + 2], P[BASE + 3]);   \
    unsigned b0 = cvtpk(P[BASE + 4], P[BASE + 5]), b1 = cvtpk(P[BASE + 6], P[BASE + 7]);                              \
    auto r0 = __builtin_amdgcn_permlane32_swap(a0, b0, false, false); auto r1 = __builtin_amdgcn_permlane32_swap(a1, b1, false, false); \
    u32x4 w = {r0[0], r1[0], r0[1], r1[1]}; OUT = *reinterpret_cast<bf16x8*>(&w); } while (0)
  PK4(p0, 0, pa0); PK4(p0, 8, pa1); PK4(p1, 0, pa2); PK4(p1, 8, pa3);
#undef PK4
}
__device__ __forceinline__ void qkt(f32x16& p0, f32x16& p1, const bf16* Ks, const bf16x8* qr, int r32, int hi) {
  p0 = f32x16{}; p1 = f32x16{};
  bf16x8 kb[16];
#define KFRAG(d0_, h_) (*reinterpret_cast<const bf16x8*>((const char*)Ks + KSWZ((h_) * 32 + r32, ((d0_) * 16 + hi * 8) * 2)))
#pragma unroll
  for (int d0 = 0; d0 < 2; ++d0) { kb[2 * d0] = KFRAG(d0, 0); kb[2 * d0 + 1] = KFRAG(d0, 1); }
  SBAR();
#pragma unroll
  for (int d0 = 0; d0 < 8; ++d0) {
    p0 = __builtin_amdgcn_mfma_f32_32x32x16_bf16(kb[2 * d0], qr[d0], p0, 0, 0, 0);
    p1 = __builtin_amdgcn_mfma_f32_32x32x16_bf16(kb[2 * d0 + 1], qr[d0], p1, 0, 0, 0);
    if (d0 < 6) { kb[2 * (d0 + 2)] = KFRAG(d0 + 2, 0); kb[2 * (d0 + 2) + 1] = KFRAG(d0 + 2, 1); }
    SBAR();
  }
#undef KFRAG
}
__device__ __forceinline__ int v_st(int k, int c) { const int kk = (k & ~0xC) | ((k & 4) << 1) | ((k & 8) >> 1); return ((kk >> 3) * 4 + (c >> 5)) * 512 + ((kk & 7) * 32 + (c & 31)) * 2; }
__device__ __forceinline__ int v_rd_base(int lane) { return ((lane & 3) << 3) | (((lane >> 2) & 3) << 6) | (((lane >> 4) & 1) << 5) | (((lane >> 5) & 1) << 8); }
constexpr int v_rd_off(int d0, int ks, int half) { return d0 * 512 + ks * 4096 + half * 2048; }
template <int OFF> __device__ __forceinline__ s16x4 tr_read(int vb) {
  s16x4 r; asm volatile("ds_read_b64_tr_b16 %0, %1 offset:%2" : "=&v"(r) : "v"(vb), "i"(OFF) : "memory"); return r;
}
template <int D0> __device__ __forceinline__ void pv_one(f32x16& od, int vb, bf16x8 pa0, bf16x8 pa1, bf16x8 pa2, bf16x8 pa3) {
  const s16x4 l0 = tr_read<v_rd_off(D0, 0, 0)>(vb), h0 = tr_read<v_rd_off(D0, 0, 1)>(vb), l1 = tr_read<v_rd_off(D0, 1, 0)>(vb), h1 = tr_read<v_rd_off(D0, 1, 1)>(vb);
  const s16x4 l2 = tr_read<v_rd_off(D0, 2, 0)>(vb), h2 = tr_read<v_rd_off(D0, 2, 1)>(vb), l3 = tr_read<v_rd_off(D0, 3, 0)>(vb), h3 = tr_read<v_rd_off(D0, 3, 1)>(vb);
  asm volatile("s_waitcnt lgkmcnt(0)" ::: "memory"); SBAR();
#define PK(L, H) (bf16x8){L[0], L[1], L[2], L[3], H[0], H[1], H[2], H[3]}
  od = __builtin_amdgcn_mfma_f32_32x32x16_bf16(pa0, PK(l0, h0), od, 0, 0, 0);
  od = __builtin_amdgcn_mfma_f32_32x32x16_bf16(pa1, PK(l1, h1), od, 0, 0, 0);
  od = __builtin_amdgcn_mfma_f32_32x32x16_bf16(pa2, PK(l2, h2), od, 0, 0, 0);
  od = __builtin_amdgcn_mfma_f32_32x32x16_bf16(pa3, PK(l3, h3), od, 0, 0, 0);
#undef PK
}
__device__ __forceinline__ void pv_d0(f32x16* o, int vb, bf16x8 pa0, bf16x8 pa1, bf16x8 pa2, bf16x8 pa3) {
  pv_one<0>(o[0], vb, pa0, pa1, pa2, pa3); pv_one<1>(o[1], vb, pa0, pa1, pa2, pa3); pv_one<2>(o[2], vb, pa0, pa1, pa2, pa3); pv_one<3>(o[3], vb, pa0, pa1, pa2, pa3);
}
__device__ __forceinline__ unsigned pk4_fp8(float a, float b, float c, float d) { int w = __builtin_amdgcn_cvt_pk_fp8_f32(a, b, 0, false); w = __builtin_amdgcn_cvt_pk_fp8_f32(c, d, w, true); return (unsigned)w; }
constexpr int KB_BYTES = 8192, VB_BYTES = 16384, LDS_KOFF = 0, LDS_VOFF = 2 * KB_BYTES, LDS_WSOFF = 131072;
#define WAIT_BAR0() asm volatile("s_waitcnt vmcnt(0) lgkmcnt(0)\n\ts_barrier" ::: "memory")
typedef float f32x4 __attribute__((ext_vector_type(4)));
typedef int v8i __attribute__((ext_vector_type(8)));
typedef int v4i __attribute__((ext_vector_type(4)));
constexpr float THR8L = 4.328f;
__device__ __forceinline__ void attn_unit_v256(const unsigned char* __restrict__ Qb, const unsigned char* __restrict__ Kh, const unsigned char* __restrict__ Vh, float* Ob, int seq, char* lds,
                                               int mode, const float* O1b, unsigned short* AOb, float lam, const float* gain, float gmul, int wid0) {
  const int tid = opaque_tid(wid0), wid = __builtin_amdgcn_readfirstlane(tid >> 6), lane = tid & 63, r32 = lane & 31, hi = lane >> 5;
  typedef __attribute__((address_space(3))) unsigned char* lptr;
  const lptr l3 = (lptr)lds;
  float* ws = (float*)(lds + LDS_WSOFF) + wid * 64; float* li_l = ws; float* al_l = ws + 32;
  const char* kg = (const char*)Kh + wid * 1024 + lane * 16; const char* vg = (const char*)Vh + wid * 1024 + lane * 16;
#define LDSP(off_) ((__attribute__((address_space(3))) unsigned*)(l3 + (off_)))
#define DMA_TILE(t, kbuf, vbuf) do { const char* kt_ = kg + (size_t)(t) * KB_BYTES; const char* vt_ = vg + (size_t)(t) * VB_BYTES; \
      __builtin_amdgcn_global_load_lds((const unsigned*)kt_, LDSP(LDS_KOFF + (kbuf) * KB_BYTES + wid * 1024), 16, 0, 0); \
      __builtin_amdgcn_global_load_lds((const unsigned*)vt_, LDSP(LDS_VOFF + (vbuf) * VB_BYTES + wid * 1024), 16, 0, 0); \
      __builtin_amdgcn_global_load_lds((const unsigned*)(vt_ + 8192), LDSP(LDS_VOFF + (vbuf) * VB_BYTES + 8192 + wid * 1024), 16, 0, 0); } while (0)
  DMA_TILE(0, 0, 0);
  float m_reg = 0.f, l_reg = 0; f32x16 o[8] = {};
  v8i qf[2];
  { const unsigned char* Qw = Qb + (size_t)(wid * QBLK + r32) * DM + hi * 32;
#pragma unroll
    for (int ds = 0; ds < 2; ++ds) { const v4i a = *(const v4i*)(Qw + ds * 64), b = *(const v4i*)(Qw + ds * 64 + 16); qf[ds] = (v8i){a[0], a[1], a[2], a[3], b[0], b[1], b[2], b[3]}; } }
#define RESC8(a) do { if (__any((a) < 1.f)) { if (hi == 0) al_l[r32] = (a); asm volatile("s_waitcnt lgkmcnt(0)" ::: "memory"); \
    _Pragma("unroll") for (int d = 0; d < 8; ++d) _Pragma("unroll") for (int r = 0; r < 16; ++r) o[d][r] *= al_l[crow(r, hi)]; } } while (0)
#define LD16(off_) (*(const __attribute__((address_space(3))) v4i*)(l3 + (off_)))
#define CAT8(a_, b_) ((v8i){a_[0], a_[1], a_[2], a_[3], b_[0], b_[1], b_[2], b_[3]})
  f32x16 p0, p1; float al; const int NT = seq / KVBLK;
#define ATT_TOP(j_, SL) do { WAIT_BAR0(); if ((j_) + 1 < NT) DMA_TILE((j_) + 1, ((SL) + 1) & 1, ((SL) + 1) & 3); } while (0)
#define ATT_QK(KS) do { \
    const int kbase = LDS_KOFF + (KS) * KB_BYTES + lane * 16; \
    { const float base = 4.0f - m_reg; \
_Pragma("unroll") \
      for (int r = 0; r < 16; ++r) { p0[r] = base; p1[r] = base; } } \
_Pragma("unroll") \
    for (int ds = 0; ds < 2; ++ds) { \
      { const v4i a = LD16(kbase + ((0 * 2 + ds) * 2 + 0) * 1024), b = LD16(kbase + ((0 * 2 + ds) * 2 + 1) * 1024); \
        p0 = __builtin_amdgcn_mfma_scale_f32_32x32x64_f8f6f4(CAT8(a, b), qf[ds], p0, 0, 0, 0, 0, 0, 0); } \
      { const v4i a = LD16(kbase + ((1 * 2 + ds) * 2 + 0) * 1024), b = LD16(kbase + ((1 * 2 + ds) * 2 + 1) * 1024); \
        p1 = __builtin_amdgcn_mfma_scale_f32_32x32x64_f8f6f4(CAT8(a, b), qf[ds], p1, 0, 0, 0, 0, 0, 0); } } } while (0)
#define ATT_SM(j_, PF) do { \
    { float pmax = p0[0]; \
_Pragma("unroll") \
      for (int r = 1; r < 16; ++r) pmax = fmaxf(pmax, p0[r]); \
_Pragma("unroll") \
      for (int r = 0; r < 16; ++r) pmax = fmaxf(pmax, p1[r]); \
      { auto rr = __builtin_amdgcn_permlane32_swap(__float_as_uint(pmax), __float_as_uint(pmax), false, false); \
        pmax = fmaxf(__uint_as_float(rr[0]), __uint_as_float(rr[1])); } \
      const float pm = pmax - 4.0f; \
      al = 1.f; \
      if (__builtin_expect((j_) == 0 || __any(pm > THR8L), 0)) { \
        const float dl = ((j_) == 0) ? pm : fmaxf(pm, 0.f); \
_Pragma("unroll") \
        for (int r = 0; r < 16; ++r) { p0[r] -= dl; p1[r] -= dl; } \
        m_reg += dl; al = ((j_) == 0) ? 1.f : __builtin_amdgcn_exp2f(-dl); } \
      float ps = 0.f; \
_Pragma("unroll") \
      for (int r = 0; r < 16; ++r) { p0[r] = __builtin_amdgcn_exp2f(p0[r]); ps += p0[r]; } \
_Pragma("unroll") \
      for (int r = 0; r < 16; ++r) { p1[r] = __builtin_amdgcn_exp2f(p1[r]); ps += p1[r]; } \
      { auto rr = __builtin_amdgcn_permlane32_swap(__float_as_uint(ps), __float_as_uint(ps), false, false); \
        ps = __uint_as_float(rr[0]) + __uint_as_float(rr[1]); } \
      l_reg = l_reg * al + ps; } \
_Pragma("unroll") \
    for (int w = 0; w < 4; ++w) { PF[w] = (int)pk4_fp8(p0[4 * w], p0[4 * w + 1], p0[4 * w + 2], p0[4 * w + 3]); PF[4 + w] = (int)pk4_fp8(p1[4 * w], p1[4 * w + 1], p1[4 * w + 2], p1[4 * w + 3]); } \
    RESC8(al); } while (0)
#define ATT_PV(PF, VS) do { \
    const int vbase = LDS_VOFF + (VS) * VB_BYTES + lane * 16; \
_Pragma("unroll") \
    for (int cb = 0; cb < 8; ++cb) { const v4i a = LD16(vbase + cb * 2048), b = LD16(vbase + cb * 2048 + 1024); \
      o[cb] = __builtin_amdgcn_mfma_scale_f32_32x32x64_f8f6f4(PF, CAT8(a, b), o[cb], 0, 0, 0, 0, 0, 0); } } while (0)
#define STEP_A(j_, SL) do { ATT_TOP(j_, SL); v8i pf; ATT_QK((SL) & 1); ATT_SM(j_, pf); ATT_PV(pf, SL); } while (0)
#define STEP_B(j_, SL) do { ATT_TOP(j_, SL); if ((j_) > 0) ATT_PV(pfb, ((SL) + 3) & 3); ATT_QK((SL) & 1); ATT_SM(j_, pfb); } while (0)
  if (wid < 4) {
    __builtin_amdgcn_s_setprio(1);
    for (int j = 0; j < NT; j += 4) { STEP_A(j, 0); STEP_A(j + 1, 1); STEP_A(j + 2, 2); STEP_A(j + 3, 3); }
  } else {
    v8i pfb = {};
    for (int j = 0; j < NT; j += 4) { STEP_B(j, 0); STEP_B(j + 1, 1); STEP_B(j + 2, 2); STEP_B(j + 3, 3); }
    ATT_PV(pfb, 3);
  }
#undef STEP_A
#undef STEP_B
#undef ATT_TOP
#undef ATT_QK
#undef ATT_SM
#undef ATT_PV
#undef LD16
#undef CAT8
  __builtin_amdgcn_s_setprio(0);
  if (hi == 0) li_l[r32] = l_reg; asm volatile("s_waitcnt lgkmcnt(0)" ::: "memory");
  float rli[16];
#pragma unroll
  for (int r = 0; r < 16; ++r) rli[r] = __builtin_amdgcn_rcpf(li_l[crow(r, hi)]);
#pragma unroll
  for (int d0 = 0; d0 < 8; ++d0) {
#pragma unroll
    for (int r = 0; r < 16; ++r) o[d0][r] *= rli[r];
    asm volatile("" : "+v"(o[d0])); }
  if (mode == 0) {
    f32x4* On = (f32x4*)Ob + wid * 2048 + lane;
#pragma unroll
    for (int d0 = 0; d0 < 8; ++d0)
#pragma unroll
      for (int rq = 0; rq < 4; ++rq) On[(d0 * 4 + rq) * 64] = (f32x4){o[d0][4 * rq], o[d0][4 * rq + 1], o[d0][4 * rq + 2], o[d0][4 * rq + 3]};
  } else {
    const f32x4* On = (const f32x4*)O1b + wid * 2048 + lane; float ssq[16];
#pragma unroll
    for (int r = 0; r < 16; ++r) ssq[r] = 0.f;
#define LD4SC1(dst, ptr) asm volatile("global_load_dwordx4 %0, %1, off sc1" : "=v"(dst) : "v"(ptr) : "memory")
#pragma unroll
    for (int d0 = 0; d0 < 8; d0 += 2) { f32x4 t[2][4];
#pragma unroll
      for (int dd = 0; dd < 2; ++dd)
#pragma unroll
        for (int rq = 0; rq < 4; ++rq) LD4SC1(t[dd][rq], On + ((d0 + dd) * 4 + rq) * 64);
      asm volatile("s_waitcnt vmcnt(0)" : "+v"(t[0][0]), "+v"(t[0][1]), "+v"(t[0][2]), "+v"(t[0][3]), "+v"(t[1][0]), "+v"(t[1][1]), "+v"(t[1][2]), "+v"(t[1][3]) :: "memory");
#pragma unroll
      for (int dd = 0; dd < 2; ++dd)
#pragma unroll
        for (int rq = 0; rq < 4; ++rq)
#pragma unroll
          for (int i = 0; i < 4; ++i) { const float d = t[dd][rq][i] - lam * o[d0 + dd][4 * rq + i]; ssq[4 * rq + i] += d * d; } }
#pragma unroll
    for (int r = 0; r < 16; ++r) { float v = ssq[r];
      v = half_sum32(v);
      ssq[r] = 1.0f / sqrtf(v * (1.f / 256.f) + 1e-6f); }
    asm volatile("s_waitcnt lgkmcnt(0)\n\ts_barrier" ::: "memory");
    { const int sb = wid * 16384 + (4 * hi) * 512 + r32 * 2; const int sbp = sb + (hi << 7), sbm = sb - (hi << 7);
#pragma unroll
      for (int d0 = 0; d0 < 8; d0 += 2) { f32x4 t[2][4];
#pragma unroll
        for (int dd = 0; dd < 2; ++dd)
#pragma unroll
          for (int rq = 0; rq < 4; ++rq) LD4SC1(t[dd][rq], On + ((d0 + dd) * 4 + rq) * 64);
        asm volatile("s_waitcnt vmcnt(0)" : "+v"(t[0][0]), "+v"(t[0][1]), "+v"(t[0][2]), "+v"(t[0][3]), "+v"(t[1][0]), "+v"(t[1][1]), "+v"(t[1][2]), "+v"(t[1][3]) :: "memory");
#pragma unroll
        for (int dd = 0; dd < 2; ++dd) { const float gl = gain[(d0 + dd) * 32 + r32] * gmul; const int sbase = (((d0 + dd) & 2) ? sbm : sbp) + (d0 + dd) * 64;
#pragma unroll
          for (int rq = 0; rq < 4; ++rq)
#pragma unroll
            for (int i = 0; i < 4; ++i) { const int r = 4 * rq + i;
              *(__attribute__((address_space(3))) unsigned short*)(l3 + sbase + (i + 8 * rq) * 512) = (unsigned short)(cvtpk((t[dd][rq][i] - lam * o[d0 + dd][r]) * ssq[r] * gl, 0.f) & 0xffffu); } } }
      const int ra = wid * 16384 + hi * 512 + r32 * 16, rb = wid * 16384 + hi * 512 + ((r32 * 16) ^ 128);
      unsigned char* Ag = (unsigned char*)AOb + (size_t)(wid * QBLK + hi) * 4096 + r32 * 16;
#pragma unroll
      for (int k = 0; k < 16; ++k) { const v4i v = *(const __attribute__((address_space(3))) v4i*)(l3 + ((k & 2) ? rb : ra) + 2 * k * 512);
        *(v4i*)(Ag + (size_t)k * 8192) = v; } }
#undef LD4SC1
  }
  WAIT_BAR0();
#undef DMA_TILE
#undef LDSP
#undef RESC8
}
#undef WAIT_BAR0
#undef KSWZ
#undef SBAR
}

constexpr size_t MiB = 1u << 20;
constexpr size_t WS_CTL = 0, CTL_ZERO_BYTES = 64 * 1024;
constexpr size_t WS_MOD = 1 * MiB;
constexpr size_t WS_ROPE = 2 * MiB;
constexpr size_t WS_WQKV = 4 * MiB;
constexpr size_t WS_WO = WS_WQKV + 48 * MiB;
constexpr size_t WS_WIN = WS_WO + 16 * MiB;
constexpr size_t WS_WOUT = WS_WIN + 48 * MiB;
constexpr size_t WS_WUP = WS_WOUT + 16 * MiB;
constexpr size_t WS_WDN = WS_WUP + 176 * MiB;
constexpr size_t WS_X = WS_WDN + 88 * MiB;
constexpr size_t WS_H = WS_X + 132 * MiB;
constexpr size_t WS_C = WS_H + 66 * MiB;
constexpr size_t WS_QKV = WS_C;
constexpr size_t WS_OP = WS_C + 198 * MiB;
constexpr size_t WS_KT = WS_OP + 132 * MiB;
constexpr size_t WS_VT = WS_KT + 66 * MiB;
constexpr size_t WS_Y = WS_C;
constexpr size_t WS_ACT = WS_C + 363 * MiB;
constexpr size_t WS_YE = WS_ACT + 182 * MiB;
constexpr size_t WS_SLAB = WS_YE + 12 * MiB;
constexpr size_t WS_PE = WS_SLAB + 16 * MiB;
constexpr size_t WS_END = WS_PE + 4 * MiB;
static_assert((size_t)R * UPW * 2 <= 363 * MiB && (size_t)R * DFF * 2 <= 182 * MiB && (size_t)R * 4096 * 4 <= 264 * MiB && (size_t)R * QKVW * 2 <= 198 * MiB, "ws map");
static_assert(WS_OP + 264 * MiB <= WS_END, "ws map");

constexpr int CW_BAR = 1024;

constexpr int RING_BYTES = 131072;
constexpr int LDS_BYTES = 147456;
constexpr int MISC_OFF = 146432;

#define GAS __attribute__((address_space(1)))
#define LAS __attribute__((address_space(3)))
typedef unsigned short bf16r;
typedef unsigned v4u __attribute__((ext_vector_type(4)));
typedef unsigned v2u __attribute__((ext_vector_type(2)));
typedef float f32x4 __attribute__((ext_vector_type(4)));
typedef GAS unsigned gu32;
#define RLX_AGENT __ATOMIC_RELAXED, __HIP_MEMORY_SCOPE_AGENT
__device__ __forceinline__ unsigned pk2(float lo, float hi) { unsigned r; asm volatile("v_cvt_pk_bf16_f32 %0, %1, %2" : "=v"(r) : "v"(lo), "v"(hi)); return r; }
__device__ __forceinline__ float bf_lo(unsigned w) { return __uint_as_float(w << 16); }
__device__ __forceinline__ float bf_hi(unsigned w) { return __uint_as_float(w & 0xffff0000u); }
__device__ __forceinline__ float wave_sum(float v) {
    v = half_sum32(v);
    const auto rr = __builtin_amdgcn_permlane32_swap(__float_as_uint(v), __float_as_uint(v), false, false);
    return __uint_as_float(rr[0]) + __uint_as_float(rr[1]);
}

#define XB_TMO      128
#define XB_XCNT(j)  (256  + 64 * (j))
#define XB_XSUB(j)  (1280 + 64 * (j))
#define XB_XGEN(j)  (2304 + 64 * (j))
#define XB_TOP      3328
#define XB_TOPGEN   3392
#define XCD_BAR_WORDS 3456
#define XB_SPIN_CAP (1u << 18)
__device__ __forceinline__ unsigned xb_ld(unsigned* p)              { return __hip_atomic_load(p, __ATOMIC_RELAXED, __HIP_MEMORY_SCOPE_AGENT); }
__device__ __forceinline__ unsigned xb_add(unsigned* p, unsigned v) { return __hip_atomic_fetch_add(p, v, __ATOMIC_RELAXED, __HIP_MEMORY_SCOPE_AGENT); }
__device__ __forceinline__ unsigned xb_xcc_id() { return (unsigned)__builtin_amdgcn_s_getreg((3 << 11) | 20) & 0xFu; }
#define XB_SPIN(cond, bar) do { unsigned _sp = 0; while (cond) { __builtin_amdgcn_s_sleep(1); \
    if ((++_sp & 255u) == 0u) { if (xb_ld(&(bar)[XB_TMO])) break; if (_sp > XB_SPIN_CAP) { atomicAdd(&(bar)[XB_TMO], 1u); break; } } } } while (0)
struct XcdBarrier { unsigned* bar; unsigned x; volatile LAS unsigned* st; };
__device__ __forceinline__ XcdBarrier xcd_barrier_post(unsigned* bar, volatile LAS unsigned* st) {
    XcdBarrier b; b.bar = bar; b.x = xb_xcc_id(); b.st = st;
    if (threadIdx.x == 0) (void)xb_add(&bar[XB_XCNT(b.x)], 1u);
    return b;
}
__device__ __forceinline__ void xcd_barrier_complete(unsigned* bar, unsigned x, unsigned& nloc, unsigned& nx) {
    const unsigned G = gridDim.x * gridDim.y * gridDim.z;
    unsigned sum, cnt, mine, sp = 0u;
    for (;;) {
        sum = 0u; cnt = 0u; mine = 0u;
#pragma unroll
        for (unsigned j = 0; j < 16; ++j) { const unsigned c = xb_ld(&bar[XB_XCNT(j)]); sum += c; cnt += (c > 0u) ? 1u : 0u; }
        if (sum == G) { mine = xb_ld(&bar[XB_XCNT(x)]); break; }
        __builtin_amdgcn_s_sleep(1);
        if ((++sp & 255u) == 0u) { if (xb_ld(&bar[XB_TMO])) break; if (sp > XB_SPIN_CAP) { atomicAdd(&bar[XB_TMO], 1u); break; } }
    }
    nloc = mine > 0u ? mine : 1u; nx = cnt > 0u ? cnt : 1u;
}
__device__ __forceinline__ void xcd_barrier(const XcdBarrier& b) {
    asm volatile("s_waitcnt vmcnt(0)" ::: "memory");
    __syncthreads();
    if (threadIdx.x == 0) {
        unsigned* bar = b.bar; unsigned bx = b.x;
        asm volatile("" : "+s"(bx));
        __builtin_amdgcn_s_waitcnt(0);
        unsigned nloc = b.st[0], nx = b.st[1];
        if (nloc == 0u) { xcd_barrier_complete(bar, bx, nloc, nx); b.st[0] = nloc; b.st[1] = nx; }
        const unsigned old = xb_add(&bar[XB_XSUB(bx)], 1u);
        const unsigned gen = old / nloc;
        if (old + 1u == (gen + 1u) * nloc) {
            __builtin_amdgcn_fence(__ATOMIC_RELEASE, "agent");
            asm volatile("s_waitcnt vmcnt(0)" ::: "memory");
            const unsigned og = xb_add(&bar[XB_TOP], 1u);
            const unsigned tg = og / nx;
            if (og + 1u == (tg + 1u) * nx) xb_add(&bar[XB_TOPGEN], 1u);
            else XB_SPIN(xb_ld(&bar[XB_TOPGEN]) == tg, bar);
            __builtin_amdgcn_fence(__ATOMIC_ACQUIRE, "agent");
            xb_add(&bar[XB_XGEN(bx)], 1u);
            asm volatile("s_waitcnt vmcnt(0)" ::: "memory");
        } else {
            XB_SPIN(xb_ld(&bar[XB_XGEN(bx)]) == gen, bar);
            __builtin_amdgcn_fence(__ATOMIC_ACQUIRE, "agent");
            asm volatile("s_waitcnt vmcnt(0)" ::: "memory");
        }
    }
    __syncthreads();
}

struct Args { const float* in[20]; float* out; unsigned char* ws; int ph_lo, ph_hi; };
struct Frame {
    LAS unsigned char* lds;
    int wid0;
    int tid, lane, wave;
    int vcu, G;
    const Args* a;
    unsigned char* ws;
};
#define REFRESH(F) do { (F).tid = opaque_tid((F).wid0); (F).lane = (F).tid & 63; (F).wave = __builtin_amdgcn_readfirstlane((F).tid >> 6); } while (0)
#define FIN(k) (F.a->in[k])
#define F_x FIN(0)
#define F_c FIN(1)
#define F_ctx FIN(2)
#define F_c_ctx FIN(3)
#define F_w_ada FIN(4)
#define F_b_ada FIN(5)
#define F_w_qkv FIN(6)
#define F_w_o FIN(7)
#define F_lq1 FIN(8)
#define F_lk1 FIN(9)
#define F_lq2 FIN(10)
#define F_lk2 FIN(11)
#define F_subln FIN(12)
#define F_w_in FIN(13)
#define F_sconv FIN(14)
#define F_w_out FIN(15)
#define F_w_up FIN(16)
#define F_fconv FIN(17)
#define F_w_dn FIN(18)
#define F_fgain FIN(19)
#define F_out (F.a->out)
#define F_MOD ((float*)(F.ws + WS_MOD))
#define F_ROPE ((float*)(F.ws + WS_ROPE))
#define F_X ((float*)(F.ws + WS_X))
#define F_OP ((float*)(F.ws + WS_OP))
#define F_KT ((bf16r*)(F.ws + WS_KT))
#define F_VT ((bf16r*)(F.ws + WS_VT))
#define F_WQKV ((bf16r*)(F.ws + WS_WQKV))
#define F_WO ((bf16r*)(F.ws + WS_WO))
#define F_WIN ((bf16r*)(F.ws + WS_WIN))
#define F_WOUT ((bf16r*)(F.ws + WS_WOUT))
#define F_WUP ((bf16r*)(F.ws + WS_WUP))
#define F_WDN ((bf16r*)(F.ws + WS_WDN))
#define F_H ((bf16r*)(F.ws + WS_H))
#define F_QKV ((bf16r*)(F.ws + WS_QKV))
#define F_Y ((bf16r*)(F.ws + WS_Y))
#define F_ACT ((bf16r*)(F.ws + WS_ACT))
#define F_YE ((float*)(F.ws + WS_YE))
#define F_SLAB ((float*)(F.ws + WS_SLAB))
#define F_PE ((float*)(F.ws + WS_PE))
#define F_GB ((bf16r*)(F.ws + WS_QKV))
#define F_CZ ((bf16r*)(F.ws + WS_QKV + 66 * MiB))

__device__ __forceinline__ unsigned pk4f8(float a, float b, float c, float d) { int w = __builtin_amdgcn_cvt_pk_fp8_f32(a, b, 0, false); w = __builtin_amdgcn_cvt_pk_fp8_f32(c, d, w, true); return (unsigned)w; }
__device__ __forceinline__ void p0_transpose_item(const float* W, int K, int N, bf16r* WT, int permk, LAS float* scr, int item, int lane, bool fp8out = false) {
    const int nblk = N / 64, kb = item / nblk, nb = item % nblk, k0 = 64 * kb, n0 = 64 * nb;
    const float* src = W + (size_t)(k0 + (lane >> 4)) * N + n0 + 4 * (lane & 15);
    LAS float* sdst = scr + (lane >> 4) * 65 + 4 * (lane & 15);
#pragma unroll
    for (int h = 0; h < 2; ++h) { f32x4 v[8];
#pragma unroll
        for (int i = 0; i < 8; ++i) v[i] = *(const GAS f32x4*)(src + (size_t)(4 * (8 * h + i)) * N);
#pragma unroll
        for (int i = 0; i < 8; ++i) { LAS float* d = sdst + 4 * (8 * h + i) * 65; d[0] = v[i].x; d[1] = v[i].y; d[2] = v[i].z; d[3] = v[i].w; } }
    asm volatile("s_waitcnt lgkmcnt(0)" ::: "memory");
    const int c = lane & 7;
    const bool il = (permk == 1) && (n0 < 4096);
    int db = n0;
    if (permk == 2) { const bool isv = n0 >= DFF; const int c0 = isv ? n0 - DFF : n0; db = (c0 >> 7) * 256 + (c0 & 127) + (isv ? 128 : 0); }
    if (permk == 3) { if (n0 < DM) db = 2 * DM + n0; else { const bool isx = n0 >= 2 * DM; const int c0 = n0 - (isx ? 2 * DM : DM); db = (c0 >> 7) * 256 + (c0 & 127) + (isx ? 128 : 0); } }
#pragma unroll
    for (int j = 0; j < 8; ++j) { const int n = (lane >> 3) + 8 * j; const LAS float* s = scr + (8 * c) * 65 + n;
        v4u o; o.x = pk2(s[0 * 65], s[1 * 65]); o.y = pk2(s[2 * 65], s[3 * 65]); o.z = pk2(s[4 * 65], s[5 * 65]); o.w = pk2(s[6 * 65], s[7 * 65]);
        const int nd = il ? (2 * (n & 31) + (n >> 5)) : n;
        if (fp8out) { constexpr float WS = 64.f;
            v2u o8; o8.x = pk4f8(WS * s[0 * 65], WS * s[1 * 65], WS * s[2 * 65], WS * s[3 * 65]); o8.y = pk4f8(WS * s[4 * 65], WS * s[5 * 65], WS * s[6 * 65], WS * s[7 * 65]);
            *(GAS v2u*)((unsigned char*)WT + (size_t)(db + nd) * K + k0 + 8 * c) = o8;
            if (permk == 1 && n0 >= 4096) {
                float r[8];
#pragma unroll
                for (int q = 0; q < 8; ++q) r[q] = WS * s[q * 65] - __builtin_amdgcn_cvt_f32_fp8((int)((q < 4 ? o8.x : o8.y) >> (8 * (q & 3))), 0);
                v2u l8; l8.x = pk4f8(r[0], r[1], r[2], r[3]); l8.y = pk4f8(r[4], r[5], r[6], r[7]);
                *(GAS v2u*)((unsigned char*)WT + (size_t)(db + nd + 2048) * K + k0 + 8 * c) = l8; } }
        else *(GAS v4u*)(WT + (size_t)(db + nd) * K + k0 + 8 * c) = o; }
    asm volatile("s_waitcnt lgkmcnt(0)" ::: "memory");
}
typedef float f32x3u __attribute__((ext_vector_type(3), aligned(4)));
__device__ __forceinline__ void p0_prologue(Frame& F) {
    REFRESH(F);
    {
        LAS float* ssl = (LAS float*)F.lds;
        LAS float* red = (LAS float*)(F.lds + 24576);
        for (int idx = F.tid; idx < 3 * DM; idx += NWAVES * 64) { const int set = idx / DM, k = idx % DM; const float v = (set < 2) ? F_c[set * DM + k] : F_c_ctx[k]; ssl[idx] = v / (1.f + __expf(-v)); }
        __syncthreads();
        for (int item = blockIdx.x; item < 256; item += F.G) {
            const int layer = item >> 6, chunk = item & 63, n0 = chunk * 192;
            const float* Wp = F_w_ada + (size_t)layer * DM * NMODW + n0 + 3 * F.lane;
            float acc[3][3];
#pragma unroll
            for (int s = 0; s < 3; ++s)
#pragma unroll
                for (int j = 0; j < 3; ++j) acc[s][j] = 0.f;
            const int kbeg = F.wave * 256;
            for (int k = kbeg; k < kbeg + 256; k += 8) {
                f32x3u w[8];
#pragma unroll
                for (int q = 0; q < 8; ++q) w[q] = *(const f32x3u*)(Wp + (size_t)(k + q) * NMODW);
#pragma unroll
                for (int q = 0; q < 8; ++q) { const float s0 = ssl[k + q], s1 = ssl[DM + k + q], s2 = ssl[2 * DM + k + q];
#pragma unroll
                    for (int j = 0; j < 3; ++j) { acc[0][j] += s0 * w[q][j]; acc[1][j] += s1 * w[q][j]; acc[2][j] += s2 * w[q][j]; } }
            }
#pragma unroll
            for (int s = 0; s < 3; ++s)
#pragma unroll
                for (int j = 0; j < 3; ++j) red[(F.wave * 9 + s * 3 + j) * 64 + F.lane] = acc[s][j];
            __syncthreads();
            for (int idx = F.tid; idx < 9 * 64; idx += NWAVES * 64) { const int q = idx >> 6, l = idx & 63, set = q / 3, j = q % 3; float sum = 0.f;
#pragma unroll
                for (int w = 0; w < 8; ++w) sum += red[(w * 9 + q) * 64 + l];
                const int col = n0 + 3 * l + j;
                F_MOD[(size_t)(layer * 3 + set) * NMODW + col] = sum + F_b_ada[layer * NMODW + col]; }
            __syncthreads();
        }
    }
    const int gw = F.vcu * NWAVES + F.wave, NGW = F.G * NWAVES;
    {
        LAS float* scr = (LAS float*)(F.lds + F.wave * 16640);
        constexpr int I_QKV = 32 * 96, I_SQ = 32 * 32, I_UP = 32 * 176, I_DN = 88 * 32;
        constexpr int E0 = 2 * I_QKV, E1 = E0 + 2 * I_SQ, E2 = E1 + 2 * I_QKV, E3 = E2 + 2 * I_SQ, E4 = E3 + 4 * I_UP, E5 = E4 + 4 * I_DN;
        for (int it = gw; it < E5; it += NGW) {
            if (it < E0) { const int m = it / I_QKV, r = it % I_QKV; p0_transpose_item(F_w_qkv + (size_t)m * DM * QKVW, DM, QKVW, (bf16r*)((unsigned char*)F_WQKV + (size_t)m * 8192 * DM), 1, scr, r, F.lane, true);   }
            else if (it < E1) { const int q = it - E0, m = q / I_SQ, r = q % I_SQ; p0_transpose_item(F_w_o + (size_t)m * DM * DM, DM, DM, F_WO + (size_t)m * DM * DM, 0, scr, r, F.lane); }
            else if (it < E2) { const int q = it - E1, m = q / I_QKV, r = q % I_QKV; p0_transpose_item(F_w_in + (size_t)m * DM * QKVW, DM, QKVW, F_WIN + (size_t)m * QKVW * DM, 3, scr, r, F.lane); }
            else if (it < E3) { const int q = it - E2, m = q / I_SQ, r = q % I_SQ; p0_transpose_item(F_w_out + (size_t)m * DM * DM, DM, DM, F_WOUT + (size_t)m * DM * DM, 0, scr, r, F.lane); }
            else if (it < E4) { const int q = it - E3, m = q / I_UP, r = q % I_UP; p0_transpose_item(F_w_up + (size_t)m * DM * UPW, DM, UPW, F_WUP + (size_t)m * UPW * DM, 2, scr, r, F.lane); }
            else { const int q = it - E4, m = q / I_DN, r = q % I_DN; p0_transpose_item(F_w_dn + (size_t)m * DFF * DM, DFF, DM, F_WDN + (size_t)m * DM * DFF, 0, scr, r, F.lane); }
        }
    }
    {
        const int gt = gw * 64 + F.lane;
        if (gt < 128 * 32) { const int pos = gt >> 5, f = gt & 31; const float angf = (float)pos * INV_FREQ[f]; const double a = (double)angf;
            const double TWO_PI = 6.283185307179586476925286766559; double r = a - TWO_PI * __builtin_rint(a / TWO_PI);
            const double r2 = r * r; double sn = 0.0, cs = 0.0;
            double ts = r, tc = 1.0;
#pragma unroll 1
            for (int i = 0; i < 14; ++i) { cs += tc; sn += ts; tc = -tc * r2 / (double)((2 * i + 1) * (2 * i + 2)); ts = -ts * r2 / (double)((2 * i + 2) * (2 * i + 3)); }
            F_ROPE[2 * gt] = (float)cs; F_ROPE[2 * gt + 1] = (float)sn; }
    }
}

__device__ __forceinline__ const float* norm_src(Frame& F, int u, bool from_input) {
    if (from_input) { const int b = u / ROWS_B, w = u % ROWS_B; return (w < SEQ) ? F_x + (size_t)(b * SEQ + w) * DM : F_ctx + (size_t)(b * CTXL + (w - SEQ)) * DM; }
    return F_X + (size_t)u * DM;
}
__device__ __forceinline__ void norm_mod_phase(Frame& F, int layer, int which, bool skip_ctx, bool from_input = false, int nslab = 0, bool ctx_from_input = false, bool fp8out = false) {
    REFRESH(F);
    const int gw = F.vcu * NWAVES + F.wave, NGW = F.G * NWAVES;
    f32x4 v[8], vn[8];
    if (gw < R) { const GAS f32x4* xr = (const GAS f32x4*)norm_src(F, gw, from_input || (ctx_from_input && (gw % ROWS_B) >= SEQ)) + F.lane;
#pragma unroll
        for (int j = 0; j < 8; ++j) v[j] = xr[64 * j]; }
    for (int u = gw; u < R; u += NGW) {
        const int un = u + NGW;
        if (un < R) { const GAS f32x4* xr = (const GAS f32x4*)norm_src(F, un, from_input || (ctx_from_input && (un % ROWS_B) >= SEQ)) + F.lane;
#pragma unroll
            for (int j = 0; j < 8; ++j) vn[j] = xr[64 * j]; }
        const int pan = u >> 8, pp = pan % PAN_B;
        if (!(skip_ctx && pp == 32)) {
            const int set = (pp == 32) ? 2 : pan / PAN_B;
            const float* sh = F_MOD + (size_t)(layer * 3 + set) * NMODW + (which ? 3 : 0) * DM; const float* sc = sh + DM;
            float ss = 0.f;
            if (nslab > 0 && pp == 32) {
                const int cr = (pan / PAN_B) * 256 + (u & 255);
                for (int k = 0; k < nslab; ++k) { const GAS f32x4* sp = (const GAS f32x4*)(F_SLAB + ((size_t)k * 512 + cr) * DM) + F.lane;
#pragma unroll
                    for (int j = 0; j < 8; ++j) v[j] += sp[64 * j]; }
                GAS f32x4* xw = (GAS f32x4*)(F_X + (size_t)u * DM) + F.lane;
#pragma unroll
                for (int j = 0; j < 8; ++j) xw[64 * j] = v[j]; }
#pragma unroll
            for (int j = 0; j < 8; ++j) ss += (v[j].x * v[j].x + v[j].y * v[j].y) + (v[j].z * v[j].z + v[j].w * v[j].w);
            const float rstd = 1.0f / sqrtf(wave_sum(ss) * (1.f / DM) + EPS);
            GAS v2u* o8 = (GAS v2u*)(F_H + (size_t)u * DM) + F.lane; GAS unsigned* o4 = (GAS unsigned*)((unsigned char*)F_H + (size_t)u * DM) + F.lane;
#pragma unroll
            for (int j = 0; j < 8; ++j) { const f32x4 s4 = *((const f32x4*)sc + F.lane + 64 * j), h4 = *((const f32x4*)sh + F.lane + 64 * j);
                const f32x4 y = (v[j] * rstd) * (s4 + 1.0f) + h4;
                if (fp8out) o4[64 * j] = pk4f8(y.x, y.y, y.z, y.w);
                else { v2u w; w.x = pk2(y.x, y.y); w.y = pk2(y.z, y.w); o8[64 * j] = w; } }
        }
#pragma unroll
        for (int j = 0; j < 8; ++j) v[j] = vn[j];
    }
}
__device__ __forceinline__ void final_phase(Frame& F) {
    REFRESH(F);
    const int gw = F.vcu * NWAVES + F.wave, NGW = F.G * NWAVES;
    for (int m = gw; m < NBATCH * SEQ; m += NGW) {
        const int b = m / SEQ, t = m % SEQ; const size_t u = (size_t)b * ROWS_B + t;
        const GAS f32x4* xr = (const GAS f32x4*)(F_X + u * DM) + F.lane;
        f32x4 v[8]; float ss = 0.f;
#pragma unroll
        for (int j = 0; j < 8; ++j) { v[j] = xr[64 * j]; ss += (v[j].x * v[j].x + v[j].y * v[j].y) + (v[j].z * v[j].z + v[j].w * v[j].w); }
        const float rstd = 1.0f / sqrtf(wave_sum(ss) * (1.f / DM) + EPS);
        GAS f32x4* o = (GAS f32x4*)(F_out + (size_t)m * DM) + F.lane;
#pragma unroll
        for (int j = 0; j < 8; ++j) { const f32x4 g4 = *((const f32x4*)F_fgain + F.lane + 64 * j); o[64 * j] = (v[j] * rstd) * g4; }
    }
}
__device__ __forceinline__ bool seq_first(int u) { const int w = u % ROWS_B; return w == 0 || w == SEQ; }
__device__ __forceinline__ bool seq_last(int u) { const int w = u % ROWS_B; return w == SEQ - 1 || w == ROWS_B - 1; }
__device__ __forceinline__ void ffn_fix_phase(Frame& F, int layer, bool skip_ctx) {
    REFRESH(F);
    const int gw = F.vcu * NWAVES + F.wave, NGW = F.G * NWAVES;
    constexpr int NCC = DFF / 512;
    const float* cw = F_fconv + (size_t)layer * 3 * UPW;
    for (int it = gw; it < NPAN * 2 * NCC; it += NGW) {
        const int cc = it % NCC, pe = it / NCC, edge = pe & 1, pm = pe >> 1;
        if (skip_ctx && (pm % PAN_B) == 32) continue;
        const int row = pm * 256 + (edge ? 255 : 0), c0 = cc * 512 + F.lane * 8, yc = (c0 >> 7) * 256 + (c0 & 127);
        const float* ya; const float* yb; const float* yc_; bool za = false, zc = false;
        if (edge == 0) { za = seq_first(row); ya = F_YE + (size_t)((pm - 1) * 4 + 3) * UPW; yb = F_YE + (size_t)(pm * 4 + 0) * UPW; yc_ = F_YE + (size_t)(pm * 4 + 1) * UPW; }
        else { zc = seq_last(row); ya = F_YE + (size_t)(pm * 4 + 2) * UPW; yb = F_YE + (size_t)(pm * 4 + 3) * UPW; yc_ = F_YE + (size_t)((pm + 1) * 4 + 0) * UPW; }
        v4u o;
#pragma unroll
        for (int h = 0; h < 2; ++h) { f32x4 r[2];
#pragma unroll
            for (int bj = 0; bj < 2; ++bj) { const int yo = yc + bj * 128 + 4 * h;
                const f32x4 a = za ? (f32x4){0.f, 0.f, 0.f, 0.f} : *(const f32x4*)(ya + yo), b = *(const f32x4*)(yb + yo), c = zc ? (f32x4){0.f, 0.f, 0.f, 0.f} : *(const f32x4*)(yc_ + yo);
                const float* wp = cw + bj * DFF + c0 + 4 * h;
                r[bj] = *(const f32x4*)(wp) * a + *(const f32x4*)(wp + UPW) * b + *(const f32x4*)(wp + 2 * UPW) * c; }
            float t[4];
#pragma unroll
            for (int e = 0; e < 4; ++e) { const float g = r[0][e]; t[e] = g / (1.f + __expf(-g)) * r[1][e]; }
            o[2 * h] = pk2(t[0], t[1]); o[2 * h + 1] = pk2(t[2], t[3]); }
        *(GAS v4u*)(F_ACT + (size_t)row * DFF + c0) = o;
    }
}
__device__ __forceinline__ void sconv_gate_phase(Frame& F, int j, bool skip_ctx) {
    REFRESH(F);
    const int gw = F.vcu * NWAVES + F.wave, NGW = F.G * NWAVES;
    constexpr int NCC = DM / 512, NRC = R / 8;
    const float* cw = F_sconv + (size_t)j * 3 * DM;
    for (int it = gw; it < NRC * NCC; it += NGW) {
        const int cc = it % NCC, rc = it / NCC, u0 = rc * 8, c0 = cc * 512 + F.lane * 8;
        const int pm = u0 >> 8; if (skip_ctx && (pm % PAN_B) == 32) continue;
        v4u gb[8], cz[8];
#pragma unroll
        for (int q = 0; q < 8; ++q) { gb[q] = *(const GAS v4u*)(F_GB + (size_t)(u0 + q) * DM + c0); cz[q] = *(const GAS v4u*)(F_CZ + (size_t)(u0 + q) * DM + c0); }
        const int rin = u0 & 255;
        const bool e0 = (rin == 0), e1 = (rin == 248);
        float fx[8];
        if (e0 || e1) {
            const int row = e0 ? u0 : u0 + 7; const bool za = e0 && seq_first(row), zc = e1 && seq_last(row);
            const float* ya = e0 ? F_PE + (size_t)((pm - 1) * 4 + 3) * DM : F_PE + (size_t)(pm * 4 + 2) * DM;
            const float* yb = e0 ? F_PE + (size_t)(pm * 4 + 0) * DM : F_PE + (size_t)(pm * 4 + 3) * DM;
            const float* yc = e0 ? F_PE + (size_t)(pm * 4 + 1) * DM : F_PE + (size_t)((pm + 1) * 4 + 0) * DM;
#pragma unroll
            for (int h = 0; h < 2; ++h) { const int o = c0 + 4 * h;
                const f32x4 a = za ? (f32x4){0.f, 0.f, 0.f, 0.f} : *(const f32x4*)(ya + o), b = *(const f32x4*)(yb + o), c = zc ? (f32x4){0.f, 0.f, 0.f, 0.f} : *(const f32x4*)(yc + o);
                const f32x4 r = *(const f32x4*)(cw + o) * a + *(const f32x4*)(cw + DM + o) * b + *(const f32x4*)(cw + 2 * DM + o) * c;
                fx[4 * h] = r[0]; fx[4 * h + 1] = r[1]; fx[4 * h + 2] = r[2]; fx[4 * h + 3] = r[3]; } }
#pragma unroll
        for (int q = 0; q < 8; ++q) { v4u o; const bool edge = (q == 0 && e0) || (q == 7 && e1);
#pragma unroll
            for (int e = 0; e < 4; ++e) { const float ca = edge ? fx[2 * e] : bf_lo(cz[q][e]), cb2 = edge ? fx[2 * e + 1] : bf_hi(cz[q][e]);
                o[e] = pk2(bf_lo(gb[q][e]) * ca, bf_hi(gb[q][e]) * cb2); }
            *(GAS v4u*)(F_H + (size_t)(u0 + q) * DM + c0) = o; }
    }
}
__device__ __forceinline__ void attn_phase(Frame& F, bool with_ctx, int a, float lam_init, char* lds) {
    REFRESH(F);
    const int c = blockIdx.x; const int G = F.G;
    float d1 = 0.f, d2 = 0.f;
#pragma unroll
    for (int j = 0; j < 2; ++j) { const int e = F.lane + 64 * j; d1 += F_lq1[a * 128 + e] * F_lk1[a * 128 + e]; d2 += F_lq2[a * 128 + e] * F_lk2[a * 128 + e]; }
    d1 = wave_sum(d1); d2 = wave_sum(d2);
    const float lam = expf(d1) - expf(d2) + lam_init;
    const float* gain = F_subln + a * 256;
    const int nlat = 16 * 32, ntot = nlat + (with_ctx ? 16 : 0);
    for (int L = c; L < ntot; L += G) {
        int combo, qb, kstart, seq;
        if (L < nlat) { const int rnd = L / 256, idx = L % 256; combo = rnd * 8 + (idx & 7); qb = idx >> 3; kstart = 0; seq = ROWS_B; }
        else { combo = L - nlat; qb = 32; kstart = SEQ; seq = CTXL; }
        const int h = combo & 7, b = combo >> 3;
        const size_t rowq = (size_t)b * ROWS_B + (size_t)qb * 256; const int jstart = kstart >> 6;
        const unsigned char* Vh = (const unsigned char*)F_VT + ((size_t)(b * 8 + h) * 132 + jstart) * 16384;
        float* O1 = F_OP + (size_t)((b * 8 + h) * 33 + qb) * 65536;
        unsigned short* AO = (unsigned short*)F_H + rowq * DM + h * 256;
#pragma unroll 1
        for (int i = 0; i < 2; ++i) { const int hs = 2 * h + i;
            att::attn_unit_v256((const unsigned char*)F_QKV + rowq * DM + hs * 128, (const unsigned char*)F_KT + ((size_t)(b * 16 + hs) * 132 + jstart) * 8192, Vh, O1, seq, lds, i, O1, AO, lam, gain, 1.0f - lam_init, F.wid0); }
    }
}

constexpr int PH_PER_LAYER = 9, NPHASES = 1 + DEPTH * PH_PER_LAYER + 1;
__global__ void __launch_bounds__(NWAVES * 64, 2) trunk_fwd(Args args) {
    extern __shared__ __attribute__((aligned(16))) unsigned char lds[];
    Frame F;
    F.lds = (LAS unsigned char*)lds;
    F.wid0 = __builtin_amdgcn_readfirstlane((int)threadIdx.x >> 6);
    REFRESH(F);
    F.G = gridDim.x; { const int bx = blockIdx.x; F.vcu = (F.G % 8 == 0) ? (bx % 8) * (F.G / 8) + bx / 8 : bx; }
    unsigned char* ws = args.ws; F.ws = ws; F.a = &args;
    volatile LAS unsigned* MISC = (volatile LAS unsigned*)(F.lds + MISC_OFF);
    for (int u = F.tid; u < (LDS_BYTES - MISC_OFF) / 4; u += NWAVES * 64) MISC[u] = 0u;
    __syncthreads();
    const int lo = args.ph_lo, hi = args.ph_hi; (void)lo; (void)hi;
#if MK_PER_PHASE
    XcdBarrier bar; bar.bar = nullptr; bar.x = 0; bar.st = nullptr;
#define GRID_BAR() do { } while (0)
#else
    XcdBarrier bar = xcd_barrier_post((unsigned*)(ws + WS_CTL) + CW_BAR, MISC + 8);
#define GRID_BAR() xcd_barrier(bar)
#endif
#if MK_PER_PHASE
#define IN(k) (lo <= (k) && (k) < hi)
#else
#define IN(k) true
#endif
#define SEAM(k) do { if (IN(k) && IN((k) + 1)) GRID_BAR(); } while (0)

    if (IN(0)) { p0_prologue(F); }
    SEAM(0);

#pragma unroll 1
    for (int layer = 0; layer < DEPTH; ++layer) {
        const int pb = 1 + layer * PH_PER_LAYER;
        const bool ctx_update = layer < 2;
        const bool lat_only = !ctx_update;
        const int nMl = lat_only ? 64 : NPAN;
        if ((layer & 1) == 0) {
            const int a = layer >> 1;
            const float lam_init = (layer == 0) ? 0.2f : 0.4707130183435842f;
            if (IN(pb + 0)) norm_mod_phase(F, layer, 0, false, layer == 0, (layer == 2) ? 4 : 0, false, true);
            SEAM(pb + 0);
            if (IN(pb + 1)) { pg8::Gemm g{F_H, (const pg8::bf16_t*)((const unsigned char*)F_WQKV + (size_t)a * 8192 * DM), DM}; pg8::QkvOrder S{F.G, (int)blockIdx.x};
                pg8::EpiQKV E{(unsigned char*)F_QKV, F_ROPE, (unsigned char*)F_KT, (unsigned char*)F_VT, F.wid0};
                pg8::gemm_phase<pg8::EpiQKV, pg8::QkvOrder, true, true, true>(F.lds, g, S, E, F.wid0); }
            SEAM(pb + 1);

#ifndef NO_ATTN
            if (IN(pb + 2)) { attn_phase(F, ctx_update, a, lam_init, (char*)lds); __syncthreads(); }
#endif
            SEAM(pb + 2);
            if (IN(pb + 4)) { pg8::Gemm g{F_H, F_WO + (size_t)a * DM * DM, DM}; pg8::PanelOrder S; S.init(64, DM / 256, F.G, (int)blockIdx.x, 1, DM / 64, ctx_update ? 4 : 0);
                pg8::EpiResidual E{F_X, F_MOD + (size_t)(layer * 3) * NMODW + 2 * DM, NMODW, (layer == 0) ? F_x : nullptr, F_ctx, F_SLAB, (const float*)(F.ws + WS_CTL + 32768)};
                pg8::gemm_phase<pg8::EpiResidual, pg8::PanelOrder, true, true>(F.lds, g, S, E, F.wid0); }
            SEAM(pb + 4);
        } else {
            const int j = layer >> 1;
            if (IN(pb + 0)) norm_mod_phase(F, layer, 0, lat_only, false, (layer == 1) ? 4 : 0);
            SEAM(pb + 0);
            if (IN(pb + 1)) { pg8::Gemm g{F_H, F_WIN + (size_t)j * QKVW * DM, DM}; pg8::PanelOrder S; S.init(64, QKVW / 256, F.G, (int)blockIdx.x, 1, DM / 64, ctx_update ? 1 : 0);
                pg8::EpiSconv E{F_GB, F_CZ, F_PE, F_sconv + (size_t)j * 3 * DM, (PG8_LAS float*)(F.lds + RING_BYTES)};
                pg8::gemm_phase<pg8::EpiSconv, pg8::PanelOrder, true, true>(F.lds, g, S, E, F.wid0); }
            SEAM(pb + 1);
            if (IN(pb + 2)) sconv_gate_phase(F, j, lat_only);
            SEAM(pb + 2);
            if (IN(pb + 4)) { pg8::Gemm g{F_H, F_WOUT + (size_t)j * DM * DM, DM}; pg8::PanelOrder S; S.init(64, DM / 256, F.G, (int)blockIdx.x, 1, DM / 64, ctx_update ? 4 : 0);
                pg8::EpiResidual E{F_X, F_MOD + (size_t)(layer * 3) * NMODW + 2 * DM, NMODW, (layer == 0) ? F_x : nullptr, F_ctx, F_SLAB, (const float*)(F.ws + WS_CTL + 32768)};
                pg8::gemm_phase<pg8::EpiResidual, pg8::PanelOrder, true, true>(F.lds, g, S, E, F.wid0); }
            SEAM(pb + 4);
        }
        if (IN(pb + 5)) norm_mod_phase(F, layer, 1, lat_only, false, (layer <= 1) ? 4 : 0, layer == 0);
        SEAM(pb + 5);
        if (IN(pb + 6)) { pg8::Gemm g{F_H, F_WUP + (size_t)layer * UPW * DM, DM}; pg8::PanelOrder S; S.init(64, UPW / 256, F.G, (int)blockIdx.x, 1, DM / 64, ctx_update ? 1 : 0);
            pg8::EpiConvGate E{F_ACT, F_YE, F_fconv + (size_t)layer * 3 * UPW, (PG8_LAS float*)(F.lds + RING_BYTES)};
            pg8::gemm_phase<pg8::EpiConvGate, pg8::PanelOrder, true, true>(F.lds, g, S, E, F.wid0); }
        SEAM(pb + 6);
        if (IN(pb + 7)) ffn_fix_phase(F, layer, lat_only);
        SEAM(pb + 7);
        if (IN(pb + 8)) { pg8::Gemm g{F_ACT, F_WDN + (size_t)layer * DM * DFF, DFF}; pg8::PanelOrder S; S.init(64, DM / 256, F.G, (int)blockIdx.x, 1, DFF / 64, ctx_update ? 4 : 0);
            pg8::EpiResidual E{F_X, F_MOD + (size_t)(layer * 3) * NMODW + 5 * DM, NMODW, nullptr, nullptr, F_SLAB, (const float*)(F.ws + WS_CTL + 32768)};
            pg8::gemm_phase<pg8::EpiResidual, pg8::PanelOrder, true, true>(F.lds, g, S, E, F.wid0); }
        SEAM(pb + 8);
    }
    if (IN(NPHASES - 1)) final_phase(F);
#undef IN
#undef SEAM
#undef GRID_BAR
}

extern "C" void kernel_launch(void* const* d_in, const int* in_sizes, int n_in, void* d_out, int out_size, void* d_ws, size_t ws_size, hipStream_t stream) {
    static int grid = 0;
    if (grid == 0) {
        if (n_in != 20 || in_sizes[0] != NBATCH * SEQ * DM || out_size != NBATCH * SEQ * DM || ws_size < WS_END) {
            fprintf(stderr, "kernel_launch: unexpected shapes: n_in %d in0 %d out %d ws %zu (need %zu)\n", n_in, n_in > 0 ? in_sizes[0] : -1, out_size, ws_size, (size_t)WS_END); grid = -1; return; }
        int dev = 0, cus = 0, per_cu = 0;
        if (hipGetDevice(&dev) != hipSuccess || hipDeviceGetAttribute(&cus, hipDeviceAttributeMultiprocessorCount, dev) != hipSuccess) { grid = -1; return; }
        if (hipFuncSetAttribute((const void*)trunk_fwd, hipFuncAttributeMaxDynamicSharedMemorySize, LDS_BYTES) != hipSuccess) { fprintf(stderr, "kernel_launch: hipFuncSetAttribute failed\n"); grid = -1; return; }
        if (hipOccupancyMaxActiveBlocksPerMultiprocessor(&per_cu, (const void*)trunk_fwd, NWAVES * 64, LDS_BYTES) != hipSuccess || per_cu < 1)
            fprintf(stderr, "kernel_launch: note: occupancy query reports %d workgroups per CU\n", per_cu);
        (void)hipGetLastError();
        grid = cus;
    }
    if (grid < 0) return;
    (void)hipMemsetAsync((char*)d_ws + WS_CTL, 0, CTL_ZERO_BYTES, stream);
    Args a{};
    for (int i = 0; i < 20; ++i) a.in[i] = (const float*)d_in[i];
    a.out = (float*)d_out; a.ws = (unsigned char*)d_ws;
#if MK_PER_PHASE
    for (int p = 0; p < NPHASES; ++p) {
        const int k = (p - 1) % PH_PER_LAYER, layer = (p - 1) / PH_PER_LAYER;
        if (p >= 1 && p < NPHASES - 1 && (layer & 1) == 1 && k == 3) continue;
        a.ph_lo = p; a.ph_hi = p + 1;
        hipLaunchKernelGGL(trunk_fwd, dim3(grid), dim3(NWAVES * 64), LDS_BYTES, stream, a);
    }
#else
    a.ph_lo = 0; a.ph_hi = NPHASES;
    hipLaunchKernelGGL(trunk_fwd, dim3(grid), dim3(NWAVES * 64), LDS_BYTES, stream, a);
#endif
    const hipError_t le = hipPeekAtLastError();
    if (le != hipSuccess) fprintf(stderr, "kernel_launch: launch failed: %s\n", hipGetErrorName(le));
}
```

```cpp
#include <hip/hip_runtime.h>
#include <hip/hip_bf16.h>
#include <cstdio>
#include <cstdint>

#ifndef MK_PER_PHASE
#define MK_PER_PHASE 0
#endif

constexpr int DM = 2048, NBATCH = 2, SEQ = 8192, CTXL = 256, DEPTH = 4;
constexpr int ROWS_B = SEQ + CTXL;
constexpr int R = NBATCH * ROWS_B;
constexpr int PAN_B = ROWS_B / 256;
constexpr int NPAN = R / 256;
constexpr int QKVW = 6144, DFF = 5632, UPW = 2 * DFF, NMODW = 6 * DM;
constexpr float EPS = 1e-6f;
constexpr int NWAVES = 8;

__constant__ float INV_FREQ[32] = {1.f, 0.749894202f, 0.562341332f, 0.421696514f, 0.316227764f, 0.237137392f, 0.177827939f, 0.133352146f, 0.100000001f, 0.0749894157f, 0.0562341288f,
    0.0421696492f, 0.0316227786f, 0.0237137359f, 0.0177827943f, 0.0133352149f, 0.00999999978f, 0.00749894232f, 0.00562341325f, 0.00421696482f, 0.00316227786f, 0.00237137382f, 0.00177827943f,
    0.00133352145f, 0.00100000005f, 0.000749894185f, 0.000562341302f, 0.000421696546f, 0.000316227786f, 0.000237137385f, 0.00017782794f, 0.00013335215f};

__device__ __forceinline__ int opaque_tid(int wid_s) { int t; asm volatile("v_mbcnt_lo_u32_b32 %0, -1, 0\n\tv_mbcnt_hi_u32_b32 %0, -1, %0" : "=v"(t)); return wid_s * 64 + t; }

template <int X> __device__ __forceinline__ float swz_xor(float v) { return __builtin_bit_cast(float, __builtin_amdgcn_ds_swizzle(__builtin_bit_cast(int, v), (X << 10) | 0x1f)); }
__device__ __forceinline__ float half_sum32(float v) { v += swz_xor<1>(v); v += swz_xor<2>(v); v += swz_xor<4>(v); v += swz_xor<8>(v); v += swz_xor<16>(v); return v; }

namespace pg8 {
#define PG8_LAS __attribute__((address_space(3)))
typedef unsigned short bf16_t;
typedef short bf16x8 __attribute__((ext_vector_type(8)));
typedef float f32x4 __attribute__((ext_vector_type(4)));
typedef float f32x2 __attribute__((ext_vector_type(2)));
typedef unsigned u32x4 __attribute__((ext_vector_type(4)));
constexpr int BM = 256, BK = 64, HALF = 128, HTB = HALF * BK * 2  , STAGE_BYTES = 8 * HTB, NXCD = 8;

__host__ __device__ __forceinline__ int lds_byte(int r, int c) { const int st = (r >> 4) * 2 + (c >> 5), rr = r & 15, cc = c & 31, ob = rr * 64 + cc * 2; return st * 1024 + (ob ^ (((ob >> 9) & 1) << 5)); }
__host__ __device__ __forceinline__ void stage_rc(int b, int& R_, int& C_) { const int st = b / 1024, sb = b % 1024, swz = sb ^ (((sb >> 9) & 1) << 5); R_ = (st >> 1) * 16 + swz / 64; C_ = (st & 1) * 32 + (swz % 64) / 2; }
__host__ __device__ __forceinline__ int perm32(int rho) { const int n = rho >> 4, i = rho & 15; return 8 * (i >> 2) + 4 * n + (i & 3); }

struct Unit { int pm, pn, k0, nt, kpart, swap, part, pnb; };
struct Gemm { const bf16_t* A; const bf16_t* Bt; int K; };

struct PanelOrder {
    int nM, nN, nwg, G, c, ktiles, cfg;
    __device__ __forceinline__ void init(int nM_, int nN_, int G_, int c_, int skip_, int ktiles_, int ksplit_ = 0, int wgm_ = 4, int vswap_ = 0) { nM = nM_; nN = nN_; nwg = nM * nN; G = G_; c = c_; ktiles = ktiles_; cfg = skip_ | (ksplit_ << 4) | (wgm_ << 8) | (vswap_ << 16); }
    __device__ __forceinline__ bool next(int i, Unit& u) const {
        const int skip = cfg & 15, ksplit = (cfg >> 4) & 15, WGM = (cfg >> 8) & 255, vswap = cfg >> 16;
        const long L = (long)i * G + c;
        if (L >= nwg) { const int sidx = (int)(L - nwg); if (sidx >= 2 * nN * ksplit) return false;
            int ts, kp, per;
            if (ksplit == 11) { ts = sidx / 11; kp = sidx % 11; per = ktiles / 11; } else if (ksplit == 4) { ts = sidx >> 2; kp = sidx & 3; per = ktiles >> 2; } else if (ksplit == 2) { ts = sidx >> 1; kp = sidx & 1; per = ktiles >> 1; } else { ts = sidx; kp = 0; per = ktiles; }
            u.pm = (ts < nN) ? 32 : 65; u.pn = (ts < nN) ? ts : ts - nN; u.k0 = kp * per; u.nt = per; u.kpart = kp; u.swap = (vswap && u.pn >= vswap) ? 1 : 0; u.part = 0; u.pnb = u.pn; return true; }
        int wgid = (int)L; { const int q = nwg / NXCD, r = nwg % NXCD, xcd = wgid % NXCD, off = wgid / NXCD; wgid = (xcd < r ? xcd * (q + 1) : r * (q + 1) + (xcd - r) * q) + off; }
        const int nig = WGM * nN, gid = wgid / nig, fm = gid * WGM, gsz = (nM - fm) < WGM ? (nM - fm) : WGM;
        int pm = fm + ((wgid % nig) % gsz); u.pn = (wgid % nig) / gsz;
        if (skip) pm += (pm >= 32) ? 1 : 0;
        u.pm = pm; u.k0 = 0; u.nt = ktiles; u.kpart = -1; u.swap = (vswap && u.pn >= vswap) ? 1 : 0; u.part = 0; u.pnb = u.pn; return true;
    }
    __device__ __forceinline__ void a_ready(const Unit&) const {}
    __device__ __forceinline__ void done(const Unit&) const {}
};

struct QkvOrder {
    int G, c;
    __device__ __forceinline__ static void map(int nN, int L, int& pm, int& pn) {
        const int nwg = 64 * nN; int wgid = L; { const int q = nwg / NXCD, xcd = wgid % NXCD, off = wgid / NXCD; wgid = xcd * q + off; }
        const int nig = 4 * nN; pm = (wgid / nig) * 4 + ((wgid % nig) & 3); pn = (wgid % nig) >> 2; pm += (pm >= 32) ? 1 : 0;
    }
    __device__ __forceinline__ bool next(int i, Unit& u) const {
        u.k0 = 0; u.nt = DM / 128; u.kpart = -1;
        const int nq = (1024 - c + G - 1) / G, nv = (512 - c + G - 1) / G;
        if (i < nq) { map(16, i * G + c, u.pm, u.pn); u.swap = 0; u.part = 0; u.pnb = u.pn; return true; }
        i -= nq;
        if (i < 2 * nv) { int pn; map(8, (i >> 1) * G + c, u.pm, pn); u.pn = 16 + pn; u.swap = 1; u.part = 1 + (i & 1); u.pnb = u.pn + ((i & 1) ? 8 : 0); return true; }
        i -= 2 * nv;
        for (int x = c; x < 48; x += G) {
            if (i < 1) { if (x < 32) { u.pm = (x < 16) ? 32 : 65; u.pn = x & 15; u.swap = 0; u.part = 0; u.pnb = u.pn; }
                         else { const int y = x - 32; u.pm = (y < 8) ? 32 : 65; u.pn = 16 + (y & 7); u.swap = 1; u.part = 0; u.pnb = u.pn; }
                         return true; }
            i -= 1; }
        return false;
    }
    __device__ __forceinline__ void a_ready(const Unit&) const {}
    __device__ __forceinline__ void done(const Unit&) const {}
};

__device__ __forceinline__ unsigned cvt_pk_bf16(float lo, float hi) { unsigned r; asm volatile("v_cvt_pk_bf16_f32 %0, %1, %2" : "=v"(r) : "v"(lo), "v"(hi)); return r; }

struct EpiStoreBf16 {
    static constexpr bool PERM = true, AFTER_DRAIN = false, SIMPLE_STORE = true;
    bf16_t* O; int ldc;
    __device__ __forceinline__ void operator()(const f32x4 (&acc)[2][2][4][2], const Unit& u, int wr, int wc, int fr, int fq) const {
        const int row0 = u.pm * BM + wr * 64 + fr; const int col0 = u.pn * BM + wc * 32 + 8 * fq;
#pragma unroll
        for (int ai = 0; ai < 2; ++ai)
#pragma unroll
            for (int m = 0; m < 4; ++m) { bf16_t* rowp = O + (size_t)(row0 + ai * HALF + m * 16) * ldc + col0;
#pragma unroll
                for (int bj = 0; bj < 2; ++bj) { const f32x4 v0 = acc[ai][bj][m][0], v1 = acc[ai][bj][m][1];
                    u32x4 w; w.x = cvt_pk_bf16(v0[0], v0[1]); w.y = cvt_pk_bf16(v0[2], v0[3]); w.z = cvt_pk_bf16(v1[0], v1[1]); w.w = cvt_pk_bf16(v1[2], v1[3]);
                    *(u32x4*)(rowp + bj * HALF) = w; } }
    }
};
__device__ __forceinline__ long lane_off(int o) { asm volatile("" : "+v"(o)); return (long)o; }
__device__ __forceinline__ unsigned pk4_fp8(float a, float b, float c, float d) {
    int w = __builtin_amdgcn_cvt_pk_fp8_f32(a, b, 0, false); w = __builtin_amdgcn_cvt_pk_fp8_f32(c, d, w, true); return (unsigned)w; }
typedef unsigned u32x2 __attribute__((ext_vector_type(2)));
struct EpiQKV {
    static constexpr bool PERM = true, AFTER_DRAIN = false, SIMPLE_STORE = true;
    unsigned char* Q8; const float* rope; unsigned char* KT; unsigned char* VT; int wid0;
    __device__ __forceinline__ void operator()(const f32x4 (&acc)[2][2][4][2], const Unit& u, int wr_, int wc_, int fr_, int fq_) const {
        const int tid_ = opaque_tid(wid0), wid_ = __builtin_amdgcn_readfirstlane(tid_ >> 6), lane_ = tid_ & 63, wr = wid_ >> 2, wc = wid_ & 3, fr = lane_ & 15, fq = lane_ >> 4;
        (void)wr_; (void)wc_; (void)fr_; (void)fq_;
        const int pp = u.pm % PAN_B, bb = u.pm / PAN_B;
        if (u.swap) {
            const int hh_ = u.pn - 16;
#pragma unroll
            for (int ai = 0; ai < 2; ++ai)
#pragma unroll
                for (int m = 0; m < 4; ++m) { const int vc = ai * HALF + wr * 64 + m * 16 + fr, cb = vc >> 5, nn = vc & 31;
#pragma unroll
                    for (int bj = 0; bj < 2; ++bj) { const int jt = pp * 4 + 2 * bj + (wc >> 1), f = wc & 1;
                        unsigned char* img = VT + (size_t)((bb * 8 + hh_) * 132 + jt) * 16384 + lane_off(cb * 2048 + f * 1024 + 4 * fq + nn * 16);
                        const f32x4 v0 = acc[ai][bj][m][0], v1 = acc[ai][bj][m][1];
                        constexpr float IW = 1.f / 64.f;
                        *(unsigned*)(img) = pk4_fp8(v0[0] * IW, v0[1] * IW, v0[2] * IW, v0[3] * IW);
                        *(unsigned*)(img + 512) = pk4_fp8(v1[0] * IW, v1[1] * IW, v1[2] * IW, v1[3] * IW); } }
            return; }
        const bool do_rope = (pp != 32);
        const int t0 = pp * 256 + wr * 64 + fr; const int f0 = 16 * (wc & 1) + 4 * fq;
        const int cl = wc * 32 + 8 * fq;
#pragma unroll
        for (int ai = 0; ai < 2; ++ai)
#pragma unroll
            for (int m = 0; m < 4; ++m) { const int rowu = u.pm * BM + ai * HALF + wr * 64 + m * 16 + fr;
                const int jt = pp * 4 + 2 * ai + wr, kr = 16 * m + fr;
                f32x4 cs0 = (f32x4){1.f, 0.f, 1.f, 0.f}, cs1 = cs0;
                if (do_rope) { const int t = t0 + ai * HALF + m * 16; const int pos = (wc < 2) ? (t >> 6) : (t & 63);
                    const f32x4* cp = (const f32x4*)(rope + (size_t)(pos * 32 + f0) * 2); cs0 = cp[0]; cs1 = cp[1]; }
#pragma unroll
                for (int bj = 0; bj < 2; ++bj) { const f32x4 v0 = acc[ai][bj][m][0], v1 = acc[ai][bj][m][1];
                    const float a0 = v0[0] * cs0[0] - v0[1] * cs0[1], a1 = v0[1] * cs0[0] + v0[0] * cs0[1];
                    const float a2 = v0[2] * cs0[2] - v0[3] * cs0[3], a3 = v0[3] * cs0[2] + v0[2] * cs0[3];
                    const float b0 = v1[0] * cs1[0] - v1[1] * cs1[1], b1 = v1[1] * cs1[0] + v1[0] * cs1[1];
                    const float b2 = v1[2] * cs1[2] - v1[3] * cs1[3], b3 = v1[3] * cs1[2] + v1[2] * cs1[3];
                    constexpr float SQC = 0.3570958286295132f / 64.f;
                    u32x2 w; w.x = pk4_fp8(a0 * SQC, a1 * SQC, a2 * SQC, a3 * SQC); w.y = pk4_fp8(b0 * SQC, b1 * SQC, b2 * SQC, b3 * SQC);
                    unsigned char* dst;
                    if (u.pn < 8) dst = Q8 + lane_off(rowu * DM + u.pn * BM + bj * HALF + cl);
                    else { const int hs = (u.pn - 8) * 2 + bj;
                        dst = KT + (size_t)((bb * 16 + hs) * 132 + jt) * 8192 + lane_off((((kr >> 5) * 2 + (cl >> 6)) * 2 + ((cl >> 4) & 1)) * 1024 + ((kr & 31) + 32 * ((cl >> 5) & 1)) * 16 + (cl & 15)); }
                    *(u32x2*)dst = w; } }
    }
};
struct EpiResidual {
    static constexpr bool PERM = false, AFTER_DRAIN = false, SIMPLE_STORE = false;
    float* X; const float* gate3; int gstride; const float* xin; const float* cin; float* slab; const float* zeros;
    __device__ __forceinline__ void operator()(const f32x4 (&acc)[2][2][4][2], const Unit& u, int wr, int wc, int fr, int fq) const {
        const int pp = u.pm % PAN_B, bb = u.pm / PAN_B; const int set = (pp == 32) ? 2 : bb;
        const float* g = gate3 + (size_t)set * gstride;
        const int col0 = u.pn * BM + wc * 32 + 4 * fq;
        f32x4 gv[2][2];
#pragma unroll
        for (int bj = 0; bj < 2; ++bj)
#pragma unroll
            for (int n = 0; n < 2; ++n) gv[bj][n] = *(const f32x4*)(g + col0 + bj * HALF + n * 16);
        const bool part = u.kpart >= 0;
        float* dstb = part ? slab + ((size_t)u.kpart * 512 + (size_t)bb * 256) * DM : X + (size_t)u.pm * BM * DM;
        const float* srcb = part ? zeros : (xin ? ((pp == 32) ? cin + (size_t)bb * CTXL * DM : xin + (size_t)(bb * SEQ + pp * 256) * DM) : X + (size_t)u.pm * BM * DM);
        const size_t sstr = part ? 0 : DM;
#pragma unroll
        for (int ai = 0; ai < 2; ++ai)
#pragma unroll
            for (int m = 0; m < 4; ++m) { const int rr = ai * HALF + wr * 64 + m * 16 + fr; float* rowp = dstb + (size_t)rr * DM + col0; const float* rowb = srcb + (size_t)rr * sstr + col0;
#pragma unroll
                for (int bj = 0; bj < 2; ++bj)
#pragma unroll
                    for (int n = 0; n < 2; ++n) { const f32x4 x = *(const f32x4*)(rowb + bj * HALF + n * 16); *(f32x4*)(rowp + bj * HALF + n * 16) = x + gv[bj][n] * acc[ai][bj][m][n]; }
                if (m & 1) asm volatile("" ::: "memory"); }
    }
};
struct EpiResidualNorm {
    static constexpr bool PERM = true, AFTER_DRAIN = false, SIMPLE_STORE = false;
    float* X; const float* gate3; const float* xin; float* slab; const float* zeros; const float* va; void* dst; float* xbuf; unsigned* cnt; unsigned want; PG8_LAS float* T; int wid0; int mode;
    __device__ __forceinline__ void operator()(f32x4 (&acc)[2][2][4][2], const Unit& u, int wr, int wc, int fr, int fq) const {
        const int pp = u.pm % PAN_B, bb = u.pm / PAN_B; const int set = (pp == 32) ? 2 : bb;
        const float* g = gate3 + (size_t)set * NMODW;
        const int col0 = u.pn * BM + wc * 32 + 8 * fq;
        PG8_LAS float* P = T; PG8_LAS float* S = T + 1024;
        {   f32x4 gv[2][2];
#pragma unroll
            for (int bj = 0; bj < 2; ++bj)
#pragma unroll
                for (int n = 0; n < 2; ++n) gv[bj][n] = *(const f32x4*)(g + col0 + bj * HALF + 4 * n);
            const bool part = u.kpart >= 0;
            float* xb = (part ? slab + ((size_t)u.kpart * 512 + (size_t)bb * 256) * DM : X + (size_t)u.pm * BM * DM) + col0;
            const float* sb = (part ? zeros : (xin ? xin + (size_t)(bb * SEQ + pp * 256) * DM : X + (size_t)u.pm * BM * DM)) + col0;
            const size_t sstr = part ? 0 : DM;
#pragma unroll
            for (int ai = 0; ai < 2; ++ai)
#pragma unroll
                for (int mb = 0; mb < 4; mb += 2) { f32x4 t[2][2][2];
#pragma unroll
                    for (int mm = 0; mm < 2; ++mm) { const float* rowb = sb + (size_t)(ai * HALF + wr * 64 + (mb + mm) * 16 + fr) * sstr;
#pragma unroll
                        for (int bj = 0; bj < 2; ++bj)
#pragma unroll
                            for (int n = 0; n < 2; ++n) t[mm][bj][n] = *(const f32x4*)(rowb + bj * HALF + 4 * n); }
#pragma unroll
                    for (int mm = 0; mm < 2; ++mm) { const int m = mb + mm, rr = ai * HALF + wr * 64 + m * 16 + fr; float* rowx = xb + (size_t)rr * DM; float q = 0.f;
#pragma unroll
                        for (int bj = 0; bj < 2; ++bj)
#pragma unroll
                            for (int n = 0; n < 2; ++n) { const f32x4 x = t[mm][bj][n] + gv[bj][n] * acc[ai][bj][m][n]; acc[ai][bj][m][n] = x;
                                if (mode != 2) *(f32x4*)(rowx + bj * HALF + 4 * n) = x;
                                q += (x[0] * x[0] + x[1] * x[1]) + (x[2] * x[2] + x[3] * x[3]); }
                        q += swz_xor<16>(q);
                        { auto r2 = __builtin_amdgcn_permlane32_swap(__float_as_uint(q), __float_as_uint(q), false, false); q = __uint_as_float(r2[0]) + __uint_as_float(r2[1]); }
                        if (fq == 0) P[rr * 4 + wc] = q; }
                    asm volatile("" ::: "memory"); } }
        const bool whole = u.kpart < 0;
        asm volatile("s_waitcnt lgkmcnt(0)\n\ts_barrier" ::: "memory");
        const int tid = opaque_tid(wid0), wid = __builtin_amdgcn_readfirstlane(tid >> 6), lane = tid & 63;
        const int row = wid * 32 + (lane & 31);
        float* slot = xbuf + ((size_t)u.pm * BM + row) * 8;
        if (whole && lane < 32) { const float t = (P[row * 4 + 0] + P[row * 4 + 1]) + (P[row * 4 + 2] + P[row * 4 + 3]);
            __hip_atomic_store(slot + u.pn, t, __ATOMIC_RELAXED, __HIP_MEMORY_SCOPE_AGENT); }
        asm volatile("s_waitcnt vmcnt(0)" ::: "memory");
        if (whole && lane == 0) __hip_atomic_fetch_add(cnt + 64 * u.pm, 1u, __ATOMIC_RELAXED, __HIP_MEMORY_SCOPE_AGENT);
        if (whole && wid == 0) {
            for (int it = 0; it < (1 << 22); ++it) {
                if ((unsigned)__builtin_amdgcn_readfirstlane(__hip_atomic_load(cnt + 64 * u.pm, __ATOMIC_RELAXED, __HIP_MEMORY_SCOPE_AGENT)) >= want) break;
                __builtin_amdgcn_s_sleep(2); }
            __builtin_amdgcn_fence(__ATOMIC_ACQUIRE, "agent"); }
        asm volatile("s_waitcnt vmcnt(0) lgkmcnt(0)\n\ts_barrier" ::: "memory");
        if (whole && lane < 32) { float t[8];
#pragma unroll
            for (int k = 0; k < 8; ++k) t[k] = __hip_atomic_load(slot + k, __ATOMIC_RELAXED, __HIP_MEMORY_SCOPE_AGENT);
            const float ss = ((t[0] + t[1]) + (t[2] + t[3])) + ((t[4] + t[5]) + (t[6] + t[7]));
            S[row] = 1.0f / sqrtf(ss * (1.f / DM) + 1e-6f); }
        asm volatile("s_waitcnt vmcnt(0) lgkmcnt(0)\n\ts_barrier" ::: "memory");
        const float* pa = va + ((mode == 2) ? (size_t)0 : (size_t)bb * NMODW) + col0;
        if (whole)
#pragma unroll
        for (int bj = 0; bj < 2; ++bj) {
            const f32x4 a0 = *(const f32x4*)(pa + bj * HALF), a1 = *(const f32x4*)(pa + bj * HALF + 4);
            if (mode == 2) {
                float* dstb = (float*)dst + ((size_t)bb * SEQ + (size_t)pp * BM) * DM + col0 + bj * HALF;
#pragma unroll
                for (int ai = 0; ai < 2; ++ai)
#pragma unroll
                    for (int m = 0; m < 4; ++m) { const int rr = ai * HALF + wr * 64 + m * 16 + fr; const float rs = S[rr]; float* rowp = dstb + (size_t)rr * DM;
                        *(f32x4*)(rowp) = (acc[ai][bj][m][0] * rs) * a0; *(f32x4*)(rowp + 4) = (acc[ai][bj][m][1] * rs) * a1; }
            } else {
                const f32x4 s0 = *(const f32x4*)(pa + DM + bj * HALF) + 1.0f, s1 = *(const f32x4*)(pa + DM + bj * HALF + 4) + 1.0f;
#pragma unroll
                for (int ai = 0; ai < 2; ++ai)
#pragma unroll
                    for (int m = 0; m < 4; ++m) { const int rr = ai * HALF + wr * 64 + m * 16 + fr; const float rs = S[rr];
                        const f32x4 y0 = (acc[ai][bj][m][0] * rs) * s0 + a0, y1 = (acc[ai][bj][m][1] * rs) * s1 + a1;
                        if (mode == 1) { u32x4 w; w.x = cvt_pk_bf16(y0[0], y0[1]); w.y = cvt_pk_bf16(y0[2], y0[3]); w.z = cvt_pk_bf16(y1[0], y1[1]); w.w = cvt_pk_bf16(y1[2], y1[3]);
                            *(u32x4*)((bf16_t*)dst + (size_t)(u.pm * BM + rr) * DM + col0 + bj * HALF) = w; }
                        else { u32x2 w; w.x = pk4_fp8(y0[0], y0[1], y0[2], y0[3]); w.y = pk4_fp8(y1[0], y1[1], y1[2], y1[3]);
                            *(u32x2*)((unsigned char*)dst + (size_t)(u.pm * BM + rr) * DM + col0 + bj * HALF) = w; } }
            }
        }
    }
};
__device__ __forceinline__ float dpp_ror1(float v) { return __builtin_bit_cast(float, __builtin_amdgcn_update_dpp(__builtin_bit_cast(int, v), __builtin_bit_cast(int, v), 0x121, 0xf, 0xf, true)); }
__device__ __forceinline__ float dpp_rol1(float v) { return __builtin_bit_cast(float, __builtin_amdgcn_update_dpp(__builtin_bit_cast(int, v), __builtin_bit_cast(int, v), 0x12F, 0xf, 0xf, true)); }
__device__ __forceinline__ float shr1_or(float v, float o) { return __builtin_bit_cast(float, __builtin_amdgcn_update_dpp(__builtin_bit_cast(int, o), __builtin_bit_cast(int, v), 0x111, 0xf, 0xf, false)); }
__device__ __forceinline__ float shl1_or(float v, float o) { return __builtin_bit_cast(float, __builtin_amdgcn_update_dpp(__builtin_bit_cast(int, o), __builtin_bit_cast(int, v), 0x101, 0xf, 0xf, false)); }
#define PG8_FMAC_DPP(c_, src_, w_, CTRL) asm("v_fmac_f32_dpp %0, %1, %2 " CTRL " row_mask:0xf bank_mask:0xf" : "+v"(c_) : "v"(src_), "v"(w_))
struct EpiConvGate {
    static constexpr bool PERM = true, AFTER_DRAIN = false, SIMPLE_STORE = false;
    bf16_t* ACT; float* YE; const float* cw; PG8_LAS float* E; float* YS;
    __device__ __forceinline__ void operator()(const f32x4 (&acc)[2][2][4][2], const Unit& u, int wr, int wc, int fr, int fq) const {
        const int cb = wc * 32 + 8 * fq;
        const bool is0 = (fr == 0), is15 = (fr == 15);
        const bool part = (YS != nullptr) && (u.pm % PAN_B) == 32;
        if (part) { float* yb = YS + ((size_t)u.kpart * 512 + (size_t)(u.pm / PAN_B) * 256 + wr * 64 + fr) * UPW + u.pn * 256 + cb;
#pragma unroll
            for (int ai = 0; ai < 2; ++ai)
#pragma unroll
                for (int m = 0; m < 4; ++m)
#pragma unroll
                    for (int bj = 0; bj < 2; ++bj)
#pragma unroll
                        for (int n = 0; n < 2; ++n) *(f32x4*)(yb + (size_t)(ai * HALF + m * 16) * UPW + bj * 128 + 4 * n) = acc[ai][bj][m][n]; }
        if (!part)
#pragma unroll
        for (int ai = 0; ai < 2; ++ai) { const int q = 2 * ai + wr;
#pragma unroll
            for (int bj = 0; bj < 2; ++bj)
#pragma unroll
                for (int n = 0; n < 2; ++n) {
                    if (is0) *(PG8_LAS f32x4*)(E + (q * 2 + 0) * 256 + bj * 128 + cb + 4 * n) = acc[ai][bj][0][n];
                    if (is15) *(PG8_LAS f32x4*)(E + (q * 2 + 1) * 256 + bj * 128 + cb + 4 * n) = acc[ai][bj][3][n]; } }
        f32x4 w[3][2][2];
#pragma unroll
        for (int j = 0; j < 3; ++j)
#pragma unroll
            for (int bj = 0; bj < 2; ++bj)
#pragma unroll
                for (int n = 0; n < 2; ++n) w[j][bj][n] = *(const f32x4*)(cw + (size_t)j * UPW + bj * DFF + u.pn * 128 + cb + 4 * n);
        if (!part) {   float* ye = YE + (size_t)u.pm * 4 * UPW + u.pn * 256 + cb;
            if (wr == 0 && fr < 2) {
#pragma unroll
                for (int bj = 0; bj < 2; ++bj)
#pragma unroll
                    for (int n = 0; n < 2; ++n) *(f32x4*)(ye + (size_t)fr * UPW + bj * 128 + 4 * n) = acc[0][bj][0][n]; }
            if (wr == 1 && fr >= 14) {
#pragma unroll
                for (int bj = 0; bj < 2; ++bj)
#pragma unroll
                    for (int n = 0; n < 2; ++n) *(f32x4*)(ye + (size_t)(fr - 12) * UPW + bj * 128 + 4 * n) = acc[1][bj][3][n]; } }
        asm volatile("s_waitcnt lgkmcnt(0)\n\ts_barrier" ::: "memory");
        if (!part)
#pragma unroll
        for (int ai = 0; ai < 2; ++ai) { const int q = 2 * ai + wr;
            f32x4 ep[2][2], en[2][2];
#pragma unroll
            for (int bj = 0; bj < 2; ++bj)
#pragma unroll
                for (int n = 0; n < 2; ++n) { ep[bj][n] = (f32x4){0.f, 0.f, 0.f, 0.f}; en[bj][n] = ep[bj][n];
                    if (is0 && q > 0) ep[bj][n] = *(const PG8_LAS f32x4*)(E + ((q - 1) * 2 + 1) * 256 + bj * 128 + cb + 4 * n);
                    if (is15 && q < 3) en[bj][n] = *(const PG8_LAS f32x4*)(E + ((q + 1) * 2 + 0) * 256 + bj * 128 + cb + 4 * n); }
#pragma unroll
            for (int m = 0; m < 4; ++m) { u32x4 ow;
#pragma unroll
                for (int n = 0; n < 2; ++n) { f32x4 cv[2];
#pragma unroll
                    for (int bj = 0; bj < 2; ++bj) { const f32x4 cur = acc[ai][bj][m][n];
#pragma unroll
                        for (int e = 0; e < 4; ++e) { const float w0 = w[0][bj][n][e], w2 = w[2][bj][n][e]; float c = w[1][bj][n][e] * cur[e];
                            PG8_FMAC_DPP(c, cur[e], w0, "row_shr:1");
                            if (m == 0) c = __builtin_fmaf(w0, ep[bj][n][e], c); else PG8_FMAC_DPP(c, acc[ai][bj][m > 0 ? m - 1 : 0][n][e], w0, "row_shl:15");
                            PG8_FMAC_DPP(c, cur[e], w2, "row_shl:1");
                            if (m == 3) c = __builtin_fmaf(w2, en[bj][n][e], c); else PG8_FMAC_DPP(c, acc[ai][bj][m < 3 ? m + 1 : 3][n][e], w2, "row_shr:15");
                            cv[bj][e] = c; } }
                    float a[4];
#pragma unroll
                    for (int e = 0; e < 4; ++e) { const float g = cv[0][e]; a[e] = g * __builtin_amdgcn_rcpf(1.f + __builtin_amdgcn_exp2f(-1.4426950408889634f * g)) * cv[1][e]; }
                    ow[2 * n] = cvt_pk_bf16(a[0], a[1]); ow[2 * n + 1] = cvt_pk_bf16(a[2], a[3]); }
                const bool skip = (q == 0 && m == 0 && is0) || (q == 3 && m == 3 && is15);
                if (!skip) *(u32x4*)(ACT + (size_t)(u.pm * BM + ai * HALF + wr * 64 + m * 16 + fr) * DFF + u.pn * 128 + cb) = ow; } }
    }
};

struct EpiSconv {
    static constexpr bool PERM = true, AFTER_DRAIN = false, SIMPLE_STORE = false;
    bf16_t* GB; bf16_t* CZ; float* PE; const float* cw; PG8_LAS float* E;
    __device__ __forceinline__ void operator()(const f32x4 (&acc)[2][2][4][2], const Unit& u, int wr, int wc, int fr, int fq) const {
        const int cb = wc * 32 + 8 * fq;
        if (u.pn >= 16) {
            const int row0 = u.pm * BM + wr * 64 + fr; const int col0 = (u.pn - 16) * BM + cb;
#pragma unroll
            for (int ai = 0; ai < 2; ++ai)
#pragma unroll
                for (int m = 0; m < 4; ++m) { bf16_t* rowp = GB + (size_t)(row0 + ai * HALF + m * 16) * DM + col0;
#pragma unroll
                    for (int bj = 0; bj < 2; ++bj) { const f32x4 v0 = acc[ai][bj][m][0], v1 = acc[ai][bj][m][1];
                        u32x4 w; w.x = cvt_pk_bf16(v0[0], v0[1]); w.y = cvt_pk_bf16(v0[2], v0[3]); w.z = cvt_pk_bf16(v1[0], v1[1]); w.w = cvt_pk_bf16(v1[2], v1[3]);
                        *(u32x4*)(rowp + bj * HALF) = w; } }
            return; }
        const bool is0 = (fr == 0), is15 = (fr == 15);
        f32x4 p[2][4][2];
#pragma unroll
        for (int ai = 0; ai < 2; ++ai)
#pragma unroll
            for (int m = 0; m < 4; ++m)
#pragma unroll
                for (int n = 0; n < 2; ++n) p[ai][m][n] = acc[ai][0][m][n] * acc[ai][1][m][n];
#pragma unroll
        for (int ai = 0; ai < 2; ++ai) { const int q = 2 * ai + wr;
#pragma unroll
            for (int n = 0; n < 2; ++n) {
                if (is0) *(PG8_LAS f32x4*)(E + (q * 2 + 0) * 128 + cb + 4 * n) = p[ai][0][n];
                if (is15) *(PG8_LAS f32x4*)(E + (q * 2 + 1) * 128 + cb + 4 * n) = p[ai][3][n]; } }
        f32x4 w[3][2];
#pragma unroll
        for (int j = 0; j < 3; ++j)
#pragma unroll
            for (int n = 0; n < 2; ++n) w[j][n] = *(const f32x4*)(cw + (size_t)j * DM + u.pn * 128 + cb + 4 * n);
        {   float* pe = PE + (size_t)u.pm * 4 * DM + u.pn * 128 + cb;
            if (wr == 0 && fr < 2) {
#pragma unroll
                for (int n = 0; n < 2; ++n) *(f32x4*)(pe + (size_t)fr * DM + 4 * n) = p[0][0][n]; }
            if (wr == 1 && fr >= 14) {
#pragma unroll
                for (int n = 0; n < 2; ++n) *(f32x4*)(pe + (size_t)(fr - 12) * DM + 4 * n) = p[1][3][n]; } }
        asm volatile("s_waitcnt lgkmcnt(0)\n\ts_barrier" ::: "memory");
#pragma unroll
        for (int ai = 0; ai < 2; ++ai) { const int q = 2 * ai + wr;
            f32x4 ep[2], en[2];
#pragma unroll
            for (int n = 0; n < 2; ++n) { ep[n] = (f32x4){0.f, 0.f, 0.f, 0.f}; en[n] = ep[n];
                if (is0 && q > 0) ep[n] = *(const PG8_LAS f32x4*)(E + ((q - 1) * 2 + 1) * 128 + cb + 4 * n);
                if (is15 && q < 3) en[n] = *(const PG8_LAS f32x4*)(E + ((q + 1) * 2 + 0) * 128 + cb + 4 * n); }
#pragma unroll
            for (int m = 0; m < 4; ++m) { u32x4 ow;
#pragma unroll
                for (int n = 0; n < 2; ++n) { const f32x4 cur = p[ai][m][n];
                    f32x4 pv, nx;
#pragma unroll
                    for (int e = 0; e < 4; ++e) {
                        pv[e] = shr1_or(cur[e], (m == 0) ? ep[n][e] : dpp_ror1(p[ai][m > 0 ? m - 1 : 0][n][e]));
                        nx[e] = shl1_or(cur[e], (m == 3) ? en[n][e] : dpp_rol1(p[ai][m < 3 ? m + 1 : 3][n][e])); }
                    const f32x4 c = w[0][n] * pv + w[1][n] * cur + w[2][n] * nx;
                    ow[2 * n] = cvt_pk_bf16(c[0], c[1]); ow[2 * n + 1] = cvt_pk_bf16(c[2], c[3]); }
                const bool skip = (q == 0 && m == 0 && is0) || (q == 3 && m == 3 && is15);
                if (!skip) *(u32x4*)(CZ + (size_t)(u.pm * BM + ai * HALF + wr * 64 + m * 16 + fr) * DM + u.pn * 128 + cb) = ow; } }
    }
};

template <class Epi, class Sched, bool ALIGN_EPI = false, bool SP2 = false, bool FP8 = false>
__device__ __forceinline__ void gemm_phase(PG8_LAS unsigned char* lds, const Gemm g, const Sched& S, const Epi& E, int wid0) {
#ifdef NO_GEMM
    return;
#endif
    const int tid = opaque_tid(wid0), wid = __builtin_amdgcn_readfirstlane(tid >> 6), lane = tid & 63, wr = wid >> 2, wc = wid & 3, fr = lane & 15, fq = lane >> 4;
    const int K = g.K; int nt; constexpr int ES = FP8 ? 1 : 2;
    unsigned voffA, voffB;
    { int R_, C_; stage_rc(tid * 16, R_, C_); const int Rb = Epi::PERM ? ((R_ & ~31) + perm32(R_ & 31)) : R_;
        voffA = (unsigned)(R_ * K * ES + C_ * 2); voffB = (unsigned)(Rb * K * ES + C_ * 2); }
    const size_t rstep64 = (size_t)64 * K * ES;
    const size_t kstep = (size_t)(BK * 2);
    const size_t hstep = (size_t)HALF * K * ES;
    const size_t tstep = 2 * hstep;
    const unsigned ldsw = (unsigned)wid * 1024u;
    const int aoff = lds_byte(wr * 64 + fr, fq * 8), boff = lds_byte(wc * 32 + fr, fq * 8);
#define PG8_SA(b, h) (((b) * 2 + (h)) * HTB)
#define PG8_SB(b, h) ((4 + (b) * 2 + (h)) * HTB)
#define PG8_STAGE(bufoff, gbase, voff) do { _Pragma("unroll") for (int _i = 0; _i < 2; ++_i) \
        __builtin_amdgcn_global_load_lds((const unsigned*)(((const char*)(gbase) + _i * rstep64) + (voff)), (PG8_LAS unsigned*)(lds + (bufoff) + ldsw + _i * 8192), 16, 0, 0); } while (0)
#define PG8_LDA(dst, b, h) do { if constexpr (FP8) { _Pragma("unroll") for (int m = 0; m < 4; ++m) { dst##8[m].lo = *(const PG8_LAS v4i_*)(lds + PG8_SA(b, h) + aoff + m * 2048); dst##8[m].hi = *(const PG8_LAS v4i_*)(lds + PG8_SA(b, h) + aoff + m * 2048 + 1024); } } \
        else { _Pragma("unroll") for (int m = 0; m < 4; ++m) _Pragma("unroll") for (int k = 0; k < 2; ++k) dst[m][k] = *(const PG8_LAS bf16x8*)(lds + PG8_SA(b, h) + aoff + m * 2048 + k * 1024); } } while (0)
#define PG8_LDB(dst, b, h) do { if constexpr (FP8) { _Pragma("unroll") for (int n = 0; n < 2; ++n) { dst##8[n].lo = *(const PG8_LAS v4i_*)(lds + PG8_SB(b, h) + boff + n * 2048); dst##8[n].hi = *(const PG8_LAS v4i_*)(lds + PG8_SB(b, h) + boff + n * 2048 + 1024); } } \
        else { _Pragma("unroll") for (int n = 0; n < 2; ++n) _Pragma("unroll") for (int k = 0; k < 2; ++k) dst[n][k] = *(const PG8_LAS bf16x8*)(lds + PG8_SB(b, h) + boff + n * 2048 + k * 1024); } } while (0)
#define PG8_MMA(ai, bj, At, Bt) do { __builtin_amdgcn_s_setprio(1); \
        if constexpr (FP8) { _Pragma("unroll") for (int m = 0; m < 4; ++m) _Pragma("unroll") for (int n = 0; n < 2; ++n) \
                acc[ai][bj][m][n] = __builtin_amdgcn_mfma_scale_f32_16x16x128_f8f6f4(Bt##8[n], At##8[m], acc[ai][bj][m][n], 0, 0, 0, 0, 0, 0); } \
        else { _Pragma("unroll") for (int m = 0; m < 4; ++m) _Pragma("unroll") for (int n = 0; n < 2; ++n) _Pragma("unroll") for (int k = 0; k < 2; ++k) \
            acc[ai][bj][m][n] = __builtin_amdgcn_mfma_f32_16x16x32_bf16(Bt[n][k], At[m][k], acc[ai][bj][m][n], 0, 0, 0); } \
        __builtin_amdgcn_s_setprio(0); } while (0)
#define PG8_WAIT_V(n) asm volatile("s_waitcnt vmcnt(" #n ")" ::: "memory")
#define PG8_WAIT_L(n) asm volatile("s_waitcnt lgkmcnt(" #n ")" ::: "memory")
#define PG8_BAR __builtin_amdgcn_s_barrier()
#define PG8_SCHED __builtin_amdgcn_sched_barrier(0)
    Unit cur, nxt; int ui = 0;
    if (!S.next(0, cur)) return;
    f32x4 acc[2][2][4][2];
#pragma unroll
    for (int a = 0; a < 2; ++a)
#pragma unroll
        for (int b = 0; b < 2; ++b)
#pragma unroll
            for (int m = 0; m < 4; ++m)
#pragma unroll
                for (int n = 0; n < 2; ++n) acc[a][b][m][n] = (f32x4){0.f, 0.f, 0.f, 0.f};
    bf16x8 At[4][2], B0[2][2], B1[2][2];
    typedef int v8i_ __attribute__((ext_vector_type(8))); typedef int v4i_ __attribute__((ext_vector_type(4)));
    v8i_ At8[4], B08[2], B18[2];
    const char* cA = (cur.swap ? (const char*)g.Bt + (size_t)cur.pnb * tstep : (const char*)g.A + (size_t)cur.pm * tstep) + (size_t)cur.k0 * kstep;
    const char* cB = (cur.swap ? (const char*)g.A + (size_t)cur.pm * tstep : (const char*)g.Bt + (size_t)cur.pnb * tstep) + (size_t)cur.k0 * kstep;
    nt = cur.nt;
    S.a_ready(cur);
    if constexpr (SP2) {
        PG8_STAGE(PG8_SB(0, 0), cB, voffB); PG8_STAGE(PG8_SB(0, 1), cB + hstep, voffB); PG8_STAGE(PG8_SA(0, 0), cA, voffA); PG8_STAGE(PG8_SA(0, 1), cA + hstep, voffA);
        if (wr == 1) PG8_BAR;
        PG8_WAIT_V(2); PG8_BAR;
        PG8_STAGE(PG8_SB(1, 0), cB + kstep, voffB); PG8_STAGE(PG8_SA(1, 0), cA + kstep, voffA); PG8_STAGE(PG8_SB(1, 1), cB + hstep + kstep, voffB);
        PG8_WAIT_V(6); PG8_BAR;
    } else {
        PG8_STAGE(PG8_SB(0, 0), cB, voffB); PG8_STAGE(PG8_SA(0, 0), cA, voffA); PG8_STAGE(PG8_SB(0, 1), cB + hstep, voffB); PG8_STAGE(PG8_SA(0, 1), cA + hstep, voffA);
        if (wr == 1) PG8_BAR;
        PG8_WAIT_V(4); PG8_BAR;
        PG8_STAGE(PG8_SB(1, 0), cB + kstep, voffB); PG8_STAGE(PG8_SA(1, 0), cA + kstep, voffA); PG8_STAGE(PG8_SB(1, 1), cB + hstep + kstep, voffB);
        PG8_WAIT_V(6); PG8_BAR;
    }
    for (;;) {
        const bool has_next = S.next(ui + 1, nxt);
        const char* nA = has_next ? (nxt.swap ? (const char*)g.Bt + (size_t)nxt.pnb * tstep : (const char*)g.A + (size_t)nxt.pm * tstep) + (size_t)nxt.k0 * kstep : cA;
        const char* nB = has_next ? (nxt.swap ? (const char*)g.A + (size_t)nxt.pm * tstep : (const char*)g.Bt + (size_t)nxt.pnb * tstep) + (size_t)nxt.k0 * kstep : cB;
        for (int t = 0; t < nt; t += 2) {
            const bool last = (t == nt - 2);
            const char* a1 = cA + (size_t)(t + 1) * kstep;
            const char* a2 = last ? nA : cA + (size_t)(t + 2) * kstep; const char* b2 = last ? nB : cB + (size_t)(t + 2) * kstep;
            const char* a3 = a2 + kstep; const char* b3 = b2 + kstep;
            if (last && has_next) S.a_ready(nxt);
            if constexpr (SP2) {
            PG8_LDB(B0, 0, 0); PG8_LDB(B1, 0, 1); PG8_SCHED; PG8_LDA(At, 0, 0); PG8_STAGE(PG8_SA(1, 1), a1 + hstep, voffA);
            PG8_WAIT_V(8); PG8_WAIT_L(0); PG8_BAR; PG8_MMA(0, 0, At, B0); PG8_MMA(0, 1, At, B1); PG8_BAR; PG8_SCHED;
            PG8_LDA(At, 0, 1); PG8_STAGE(PG8_SB(0, 0), b2, voffB); PG8_STAGE(PG8_SB(0, 1), b2 + hstep, voffB); PG8_STAGE(PG8_SA(0, 0), a2, voffA);
            PG8_WAIT_V(8); PG8_WAIT_L(0); PG8_BAR; PG8_MMA(1, 0, At, B0); PG8_MMA(1, 1, At, B1); PG8_BAR; PG8_SCHED;
            PG8_LDB(B0, 1, 0); PG8_LDB(B1, 1, 1); PG8_SCHED; PG8_LDA(At, 1, 0); PG8_STAGE(PG8_SA(0, 1), a2 + hstep, voffA);
            PG8_WAIT_V(8); PG8_WAIT_L(0); PG8_BAR; PG8_MMA(0, 0, At, B0); PG8_MMA(0, 1, At, B1); PG8_BAR; PG8_SCHED;
            PG8_LDA(At, 1, 1); PG8_STAGE(PG8_SB(1, 0), b3, voffB); PG8_STAGE(PG8_SB(1, 1), b3 + hstep, voffB); PG8_STAGE(PG8_SA(1, 0), a3, voffA);
            PG8_WAIT_V(8); PG8_WAIT_L(0); PG8_BAR; PG8_MMA(1, 0, At, B0); PG8_MMA(1, 1, At, B1); PG8_BAR; PG8_SCHED;
            } else {
            PG8_LDB(B0, 0, 0); PG8_SCHED; PG8_LDA(At, 0, 0); PG8_STAGE(PG8_SA(1, 1), a1 + hstep, voffA);
            PG8_WAIT_L(8); PG8_BAR; PG8_WAIT_L(0); PG8_MMA(0, 0, At, B0); PG8_BAR; PG8_SCHED;
            PG8_LDB(B1, 0, 1); PG8_STAGE(PG8_SB(0, 0), b2, voffB);
            PG8_BAR; PG8_WAIT_L(0); PG8_MMA(0, 1, At, B1); PG8_BAR;
            PG8_LDA(At, 0, 1); PG8_STAGE(PG8_SA(0, 0), a2, voffA);
            PG8_BAR; PG8_WAIT_L(0); PG8_MMA(1, 0, At, B0); PG8_BAR; PG8_SCHED;
            PG8_STAGE(PG8_SB(0, 1), b2 + hstep, voffB);
            PG8_WAIT_V(6); PG8_BAR; PG8_MMA(1, 1, At, B1); PG8_BAR;
            PG8_LDB(B0, 1, 0); PG8_SCHED; PG8_LDA(At, 1, 0); PG8_STAGE(PG8_SA(0, 1), a2 + hstep, voffA);
            PG8_WAIT_L(8); PG8_BAR; PG8_WAIT_L(0); PG8_MMA(0, 0, At, B0); PG8_BAR; PG8_SCHED;
            PG8_LDB(B1, 1, 1); PG8_STAGE(PG8_SB(1, 0), b3, voffB);
            PG8_BAR; PG8_WAIT_L(0); PG8_MMA(0, 1, At, B1); PG8_BAR;
            PG8_LDA(At, 1, 1); PG8_STAGE(PG8_SA(1, 0), a3, voffA);
            PG8_BAR; PG8_WAIT_L(0); PG8_MMA(1, 0, At, B0); PG8_BAR; PG8_SCHED;
            PG8_STAGE(PG8_SB(1, 1), b3 + hstep, voffB);
            PG8_WAIT_V(6); PG8_BAR; PG8_MMA(1, 1, At, B1); PG8_BAR;
            }
        }
        if constexpr (ALIGN_EPI) { if (wr == 0) PG8_BAR; }
        if constexpr (!Epi::AFTER_DRAIN) { if (cur.part != 1) E(acc, cur, wr, wc, fr, fq);
            S.done(cur); }
        if (!has_next) break;
        if (nxt.part != 2)
#pragma unroll
        for (int a = 0; a < 2; ++a)
#pragma unroll
            for (int b = 0; b < 2; ++b)
#pragma unroll
                for (int m = 0; m < 4; ++m)
#pragma unroll
                    for (int n = 0; n < 2; ++n) acc[a][b][m][n] = (f32x4){0.f, 0.f, 0.f, 0.f};
        cur = nxt; cA = nA; cB = nB; ++ui; nt = cur.nt;
        if constexpr (ALIGN_EPI) { if (wr == 1) PG8_BAR; }
    }
    PG8_WAIT_V(0);
    if constexpr (!ALIGN_EPI) { if (wr == 0) PG8_BAR; }
    PG8_BAR;
#undef PG8_SA
#undef PG8_SB
#undef PG8_STAGE
#undef PG8_LDA
#undef PG8_LDB
#undef PG8_MMA
#undef PG8_WAIT_V
#undef PG8_WAIT_L
#undef PG8_BAR
#undef PG8_SCHED
}
}

namespace att {
using bf16 = __hip_bfloat16;
constexpr int D = 128, NW = 8, QBLK = 32, KVBLK = 64;
constexpr float SCALE = 0.088388347648318440f;
constexpr float THR = 8.f;
constexpr int LDQ = QKVW, LDK = QKVW, LDO = 2048;
constexpr size_t SHM_V = KVBLK * D * 2, SHM_K = KVBLK * D * 2, SHM_ATTN = 2 * SHM_V + 2 * SHM_K + NW * 64 * 4;
using bf16x8 = __attribute__((ext_vector_type(8))) short;
using s16x4  = __attribute__((ext_vector_type(4))) short;
using f32x16 = __attribute__((ext_vector_type(16))) float;
using u32x4  = __attribute__((ext_vector_type(4))) unsigned;
#define KSWZ(row, colB) ((row) * 256 + ((colB) ^ (((row) & 7) << 4)))
#define SBAR() __builtin_amdgcn_sched_barrier(0)
__device__ __forceinline__ int crow(int r, int hi) { return (r & 3) + 8 * (r >> 2) + 4 * hi; }
__device__ __forceinline__ unsigned cvtpk(float lo, float hi) { unsigned r; asm volatile("v_cvt_pk_bf16_f32 %0, %1, %2" : "=v"(r) : "v"(lo), "v"(hi)); return r; }
__device__ __forceinline__ bf16x8 ld8(const bf16* p) { return *reinterpret_cast<const bf16x8*>(p); }

__device__ __forceinline__ void partialSM(f32x16& p0, f32x16& p1, float& m_reg, float& mn, float& alpha) {
  constexpr float C = SCALE * 1.4426950408889634f;
  float pmax = p0[0];
#pragma unroll
  for (int r = 1; r < 16; ++r) pmax = fmaxf(pmax, p0[r]);
#pragma unroll
  for (int r = 0; r < 16; ++r) pmax = fmaxf(pmax, p1[r]);
  { auto rr = __builtin_amdgcn_permlane32_swap(__float_as_uint(pmax), __float_as_uint(pmax), false, false);
    pmax = fmaxf(__uint_as_float(rr[0]), __uint_as_float(rr[1])); }
  if (__builtin_expect(__all(pmax - m_reg <= THR / SCALE), 1)) { mn = m_reg; alpha = 1.f; }
  else { mn = fmaxf(m_reg, pmax); alpha = __builtin_amdgcn_exp2f((m_reg - mn) * C); m_reg = mn; }
  float mnC = -mn * C;
#pragma unroll
  for (int r = 0; r < 16; ++r) p0[r] = fmaf(p0[r], C, mnC);
#pragma unroll
  for (int r = 0; r < 16; ++r) p1[r] = fmaf(p1[r], C, mnC);
#pragma unroll
  for (int r = 0; r < 16; ++r) p0[r] = __builtin_amdgcn_exp2f(p0[r]);
}
__device__ __forceinline__ void finishSM(f32x16& p0, f32x16& p1, float alpha, float& l_reg, bf16x8& pa0, bf16x8& pa1, bf16x8& pa2, bf16x8& pa3) {
#pragma unroll
  for (int r = 0; r < 16; ++r) p1[r] = __builtin_amdgcn_exp2f(p1[r]);
  float ps = 0;
#pragma unroll
  for (int r = 0; r < 16; ++r) ps += p0[r];
#pragma unroll
  for (int r = 0; r < 16; ++r) ps += p1[r];
  { auto rr = __builtin_amdgcn_permlane32_swap(__float_as_uint(ps), __float_as_uint(ps), false, false);
    ps = __uint_as_float(rr[0]) + __uint_as_float(rr[1]); }
  l_reg = l_reg * alpha + ps;
#define PK4(P, BASE, OUT) do { unsigned a0 = cvtpk(P[BASE + 0], P[BASE + 1]), a1 = cvtpk(P[BASE + 2], P[BASE + 3]);   \
    unsigned b0 = cvtpk(P[BASE + 4], P[BASE + 5]), b1 = cvtpk(P[BASE + 6], P[BASE + 7]);                              \
    auto r0 = __builtin_amdgcn_permlane32_swap(a0, b0, false, false); auto r1 = __builtin_amdgcn_permlane32_swap(a1, b1, false, false); \
    u32x4 w = {r0[0], r1[0], r0[1], r1[1]}; OUT = *reinterpret_cast<bf16x8*>(&w); } while (0)
  PK4(p0, 0, pa0); PK4(p0, 8, pa1); PK4(p1, 0, pa2); PK4(p1, 8, pa3);
#undef PK4
}
__device__ __forceinline__ void qkt(f32x16& p0, f32x16& p1, const bf16* Ks, const bf16x8* qr, int r32, int hi) {
  p0 = f32x16{}; p1 = f32x16{};
  bf16x8 kb[16];
#define KFRAG(d0_, h_) (*reinterpret_cast<const bf16x8*>((const char*)Ks + KSWZ((h_) * 32 + r32, ((d0_) * 16 + hi * 8) * 2)))
#pragma unroll
  for (int d0 = 0; d0 < 2; ++d0) { kb[2 * d0] = KFRAG(d0, 0); kb[2 * d0 + 1] = KFRAG(d0, 1); }
  SBAR();
#pragma unroll
  for (int d0 = 0; d0 < 8; ++d0) {
    p0 = __builtin_amdgcn_mfma_f32_32x32x16_bf16(kb[2 * d0], qr[d0], p0, 0, 0, 0);
    p1 = __builtin_amdgcn_mfma_f32_32x32x16_bf16(kb[2 * d0 + 1], qr[d0], p1, 0, 0, 0);
    if (d0 < 6) { kb[2 * (d0 + 2)] = KFRAG(d0 + 2, 0); kb[2 * (d0 + 2) + 1] = KFRAG(d0 + 2, 1); }
    SBAR();
  }
#undef KFRAG
}
__device__ __forceinline__ int v_st(int k, int c) { const int kk = (k & ~0xC) | ((k & 4) << 1) | ((k & 8) >> 1); return ((kk >> 3) * 4 + (c >> 5)) * 512 + ((kk & 7) * 32 + (c & 31)) * 2; }
__device__ __forceinline__ int v_rd_base(int lane) { return ((lane & 3) << 3) | (((lane >> 2) & 3) << 6) | (((lane >> 4) & 1) << 5) | (((lane >> 5) & 1) << 8); }
constexpr int v_rd_off(int d0, int ks, int half) { return d0 * 512 + ks * 4096 + half * 2048; }
template <int OFF> __device__ __forceinline__ s16x4 tr_read(int vb) {
  s16x4 r; asm volatile("ds_read_b64_tr_b16 %0, %1 offset:%2" : "=&v"(r) : "v"(vb), "i"(OFF) : "memory"); return r;
}
template <int D0> __device__ __forceinline__ void pv_one(f32x16& od, int vb, bf16x8 pa0, bf16x8 pa1, bf16x8 pa2, bf16x8 pa3) {
  const s16x4 l0 = tr_read<v_rd_off(D0, 0, 0)>(vb), h0 = tr_read<v_rd_off(D0, 0, 1)>(vb), l1 = tr_read<v_rd_off(D0, 1, 0)>(vb), h1 = tr_read<v_rd_off(D0, 1, 1)>(vb);
  const s16x4 l2 = tr_read<v_rd_off(D0, 2, 0)>(vb), h2 = tr_read<v_rd_off(D0, 2, 1)>(vb), l3 = tr_read<v_rd_off(D0, 3, 0)>(vb), h3 = tr_read<v_rd_off(D0, 3, 1)>(vb);
  asm volatile("s_waitcnt lgkmcnt(0)" ::: "memory"); SBAR();
#define PK(L, H) (bf16x8){L[0], L[1], L[2], L[3], H[0], H[1], H[2], H[3]}
  od = __builtin_amdgcn_mfma_f32_32x32x16_bf16(pa0, PK(l0, h0), od, 0, 0, 0);
  od = __builtin_amdgcn_mfma_f32_32x32x16_bf16(pa1, PK(l1, h1), od, 0, 0, 0);
  od = __builtin_amdgcn_mfma_f32_32x32x16_bf16(pa2, PK(l2, h2), od, 0, 0, 0);
  od = __builtin_amdgcn_mfma_f32_32x32x16_bf16(pa3, PK(l3, h3), od, 0, 0, 0);
#undef PK
}
__device__ __forceinline__ void pv_d0(f32x16* o, int vb, bf16x8 pa0, bf16x8 pa1, bf16x8 pa2, bf16x8 pa3) {
  pv_one<0>(o[0], vb, pa0, pa1, pa2, pa3); pv_one<1>(o[1], vb, pa0, pa1, pa2, pa3); pv_one<2>(o[2], vb, pa0, pa1, pa2, pa3); pv_one<3>(o[3], vb, pa0, pa1, pa2, pa3);
}
__device__ __forceinline__ unsigned pk4_fp8(float a, float b, float c, float d) { int w = __builtin_amdgcn_cvt_pk_fp8_f32(a, b, 0, false); w = __builtin_amdgcn_cvt_pk_fp8_f32(c, d, w, true); return (unsigned)w; }
constexpr int KB_BYTES = 8192, VB_BYTES = 16384, LDS_KOFF = 0, LDS_VOFF = 2 * KB_BYTES, LDS_WSOFF = 131072;
#define WAIT_BAR0() asm volatile("s_waitcnt vmcnt(0) lgkmcnt(0)\n\ts_barrier" ::: "memory")
typedef float f32x4 __attribute__((ext_vector_type(4)));
typedef int v8i __attribute__((ext_vector_type(8)));
typedef int v4i __attribute__((ext_vector_type(4)));
constexpr float THR8L = 4.328f;
__device__ __forceinline__ void attn_unit_v256(const unsigned char* __restrict__ Qb, const unsigned char* __restrict__ Kh, const unsigned char* __restrict__ Vh, float* Ob, int seq, char* lds,
                                               int mode, const float* O1b, unsigned short* AOb, float lam, const float* gain, float gmul, int wid0) {
  const int tid = opaque_tid(wid0), wid = __builtin_amdgcn_readfirstlane(tid >> 6), lane = tid & 63, r32 = lane & 31, hi = lane >> 5;
  typedef __attribute__((address_space(3))) unsigned char* lptr;
  const lptr l3 = (lptr)lds;
  float* ws = (float*)(lds + LDS_WSOFF) + wid * 64; float* li_l = ws; float* al_l = ws + 32;
  const char* kg = (const char*)Kh + wid * 1024 + lane * 16; const char* vg = (const char*)Vh + wid * 1024 + lane * 16;
#define LDSP(off_) ((__attribute__((address_space(3))) unsigned*)(l3 + (off_)))
#define DMA_TILE(t, kbuf, vbuf) do { const char* kt_ = kg + (size_t)(t) * KB_BYTES; const char* vt_ = vg + (size_t)(t) * VB_BYTES; \
      __builtin_amdgcn_global_load_lds((const unsigned*)kt_, LDSP(LDS_KOFF + (kbuf) * KB_BYTES + wid * 1024), 16, 0, 0); \
      __builtin_amdgcn_global_load_lds((const unsigned*)vt_, LDSP(LDS_VOFF + (vbuf) * VB_BYTES + wid * 1024), 16, 0, 0); \
      __builtin_amdgcn_global_load_lds((const unsigned*)(vt_ + 8192), LDSP(LDS_VOFF + (vbuf) * VB_BYTES + 8192 + wid * 1024), 16, 0, 0); } while (0)
  DMA_TILE(0, 0, 0);
  float m_reg = 0.f, l_reg = 0; f32x16 o[8] = {};
  v8i qf[2];
  { const unsigned char* Qw = Qb + (size_t)(wid * QBLK + r32) * DM + hi * 32;
#pragma unroll
    for (int ds = 0; ds < 2; ++ds) { const v4i a = *(const v4i*)(Qw + ds * 64), b = *(const v4i*)(Qw + ds * 64 + 16); qf[ds] = (v8i){a[0], a[1], a[2], a[3], b[0], b[1], b[2], b[3]}; } }
  int kb_l = LDS_KOFF + lane * 16; asm volatile("" : "+v"(kb_l));
  int vb_l = LDS_VOFF + lane * 16; asm volatile("" : "+v"(vb_l));
#define RESC8(a) do { if (__any((a) < 1.f)) { if (hi == 0) al_l[r32] = (a); asm volatile("s_waitcnt lgkmcnt(0)" ::: "memory"); \
    _Pragma("unroll") for (int d = 0; d < 8; ++d) _Pragma("unroll") for (int r = 0; r < 16; ++r) o[d][r] *= al_l[crow(r, hi)]; } } while (0)
#define LD16(off_) (*(const __attribute__((address_space(3))) v4i*)(l3 + (off_)))
#define CAT8(a_, b_) ((v8i){a_[0], a_[1], a_[2], a_[3], b_[0], b_[1], b_[2], b_[3]})
  f32x16 p0, p1; float al; const int NT = seq / KVBLK;
#define ATT_TOP(j_, SL) do { WAIT_BAR0(); if ((j_) + 1 < NT) DMA_TILE((j_) + 1, ((SL) + 1) & 1, ((SL) + 1) & 3); } while (0)
#define ATT_QK(KS) do { \
    const int kbase = kb_l + (KS) * KB_BYTES; \
    f32x16 bt;                            \
    { const float base = 4.0f - m_reg; \
_Pragma("unroll") \
      for (int r = 0; r < 16; ++r) bt[r] = base; } \
    { const v4i a = LD16(kbase + ((0 * 2 + 0) * 2 + 0) * 1024), b = LD16(kbase + ((0 * 2 + 0) * 2 + 1) * 1024); \
      p0 = __builtin_amdgcn_mfma_scale_f32_32x32x64_f8f6f4(CAT8(a, b), qf[0], bt, 0, 0, 0, 0, 0, 0); } \
    { const v4i a = LD16(kbase + ((1 * 2 + 0) * 2 + 0) * 1024), b = LD16(kbase + ((1 * 2 + 0) * 2 + 1) * 1024); \
      p1 = __builtin_amdgcn_mfma_scale_f32_32x32x64_f8f6f4(CAT8(a, b), qf[0], bt, 0, 0, 0, 0, 0, 0); } \
    { const v4i a = LD16(kbase + ((0 * 2 + 1) * 2 + 0) * 1024), b = LD16(kbase + ((0 * 2 + 1) * 2 + 1) * 1024); \
      p0 = __builtin_amdgcn_mfma_scale_f32_32x32x64_f8f6f4(CAT8(a, b), qf[1], p0, 0, 0, 0, 0, 0, 0); } \
    { const v4i a = LD16(kbase + ((1 * 2 + 1) * 2 + 0) * 1024), b = LD16(kbase + ((1 * 2 + 1) * 2 + 1) * 1024); \
      p1 = __builtin_amdgcn_mfma_scale_f32_32x32x64_f8f6f4(CAT8(a, b), qf[1], p1, 0, 0, 0, 0, 0, 0); } } while (0)
#define ATT_SM(j_, PF) do { \
    float ps; al = 1.f; \
    if ((j_) == 0) {                      \
      float pmax = p0[0]; \
_Pragma("unroll") \
      for (int r = 1; r < 16; ++r) pmax = fmaxf(pmax, p0[r]); \
_Pragma("unroll") \
      for (int r = 0; r < 16; ++r) pmax = fmaxf(pmax, p1[r]); \
      { auto rr = __builtin_amdgcn_permlane32_swap(__float_as_uint(pmax), __float_as_uint(pmax), false, false); \
        pmax = fmaxf(__uint_as_float(rr[0]), __uint_as_float(rr[1])); } \
      const float dl = pmax - 4.0f; \
_Pragma("unroll") \
      for (int r = 0; r < 16; ++r) { p0[r] -= dl; p1[r] -= dl; } \
      m_reg += dl; ps = 0.f; \
_Pragma("unroll") \
      for (int r = 0; r < 16; ++r) { p0[r] = __builtin_amdgcn_exp2f(p0[r]); ps += p0[r]; } \
_Pragma("unroll") \
      for (int r = 0; r < 16; ++r) { p1[r] = __builtin_amdgcn_exp2f(p1[r]); ps += p1[r]; } \
    } else { float pa = 0.f, pb = 0.f; \
_Pragma("unroll") \
      for (int r = 0; r < 16; ++r) { p0[r] = __builtin_amdgcn_exp2f(p0[r]); pa += p0[r]; } \
      asm volatile("" : "+v"(pa));          \
_Pragma("unroll") \
      for (int r = 0; r < 16; ++r) { p1[r] = __builtin_amdgcn_exp2f(p1[r]); pb += p1[r]; } \
      ps = pa + pb; \
      if (__builtin_expect(__any(fmaxf(pa, pb) > 448.f), 0)) {        \
        float pmax = p0[0]; \
_Pragma("unroll") \
        for (int r = 1; r < 16; ++r) pmax = fmaxf(pmax, p0[r]); \
_Pragma("unroll") \
        for (int r = 0; r < 16; ++r) pmax = fmaxf(pmax, p1[r]); \
        { auto rr = __builtin_amdgcn_permlane32_swap(__float_as_uint(pmax), __float_as_uint(pmax), false, false); \
          pmax = fmaxf(__uint_as_float(rr[0]), __uint_as_float(rr[1])); } \
        const float dl = fmaxf(fminf(__builtin_amdgcn_logf(pmax), 126.f) - 4.0f, 0.f); \
        al = __builtin_amdgcn_exp2f(-dl); \
_Pragma("unroll") \
        for (int r = 0; r < 16; ++r) { p0[r] = fminf(p0[r] * al, 448.f); p1[r] = fminf(p1[r] * al, 448.f); }        \
        ps = 0.f; \
_Pragma("unroll") \
        for (int r = 0; r < 16; ++r) ps += p0[r] + p1[r]; \
        m_reg += dl; } } \
    { auto rr = __builtin_amdgcn_permlane32_swap(__float_as_uint(ps), __float_as_uint(ps), false, false); \
      ps = __uint_as_float(rr[0]) + __uint_as_float(rr[1]); } \
    l_reg = l_reg * al + ps; \
_Pragma("unroll") \
    for (int w = 0; w < 4; ++w) { PF[w] = (int)pk4_fp8(p0[4 * w], p0[4 * w + 1], p0[4 * w + 2], p0[4 * w + 3]); PF[4 + w] = (int)pk4_fp8(p1[4 * w], p1[4 * w + 1], p1[4 * w + 2], p1[4 * w + 3]); } \
    RESC8(al); } while (0)
#define ATT_PV(PF, VS) do { \
    const int vbase = vb_l + (VS) * VB_BYTES; \
_Pragma("unroll") \
    for (int cb = 0; cb < 8; ++cb) { const v4i a = LD16(vbase + cb * 2048), b = LD16(vbase + cb * 2048 + 1024); \
      o[cb] = __builtin_amdgcn_mfma_scale_f32_32x32x64_f8f6f4(PF, CAT8(a, b), o[cb], 0, 0, 0, 0, 0, 0); } } while (0)
#define STEP_A(j_, SL) do { ATT_TOP(j_, SL); v8i pf; ATT_QK((SL) & 1); ATT_SM(j_, pf); ATT_PV(pf, SL); } while (0)
#define STEP_B(j_, SL) do { ATT_TOP(j_, SL); if ((j_) > 0) ATT_PV(pfb, ((SL) + 3) & 3); ATT_QK((SL) & 1); ATT_SM(j_, pfb); } while (0)
  if (wid < 4) {
    __builtin_amdgcn_s_setprio(1);
    for (int j = 0; j < NT; j += 4) { STEP_A(j, 0); STEP_A(j + 1, 1); STEP_A(j + 2, 2); STEP_A(j + 3, 3); }
  } else {
    v8i pfb = {};
    for (int j = 0; j < NT; j += 4) { STEP_B(j, 0); STEP_B(j + 1, 1); STEP_B(j + 2, 2); STEP_B(j + 3, 3); }
    ATT_PV(pfb, 3);
  }
#undef STEP_A
#undef STEP_B
#undef ATT_TOP
#undef ATT_QK
#undef ATT_SM
#undef ATT_PV
#undef LD16
#undef CAT8
  __builtin_amdgcn_s_setprio(0);
  if (hi == 0) li_l[r32] = l_reg; asm volatile("s_waitcnt lgkmcnt(0)" ::: "memory");
  float rli[16];
#pragma unroll
  for (int r = 0; r < 16; ++r) rli[r] = __builtin_amdgcn_rcpf(li_l[crow(r, hi)]);
#pragma unroll
  for (int d0 = 0; d0 < 8; ++d0) {
#pragma unroll
    for (int r = 0; r < 16; ++r) o[d0][r] *= rli[r];
    asm volatile("" : "+v"(o[d0])); }
  if (mode == 0) {
    f32x4* On = (f32x4*)Ob + wid * 2048 + lane;
#pragma unroll
    for (int d0 = 0; d0 < 8; ++d0)
#pragma unroll
      for (int rq = 0; rq < 4; ++rq) On[(d0 * 4 + rq) * 64] = (f32x4){o[d0][4 * rq], o[d0][4 * rq + 1], o[d0][4 * rq + 2], o[d0][4 * rq + 3]};
  } else {
    const f32x4* On = (const f32x4*)O1b + wid * 2048 + lane; float ssq[16];
#pragma unroll
    for (int r = 0; r < 16; ++r) ssq[r] = 0.f;
#define LD4SC1(dst, ptr) asm volatile("global_load_dwordx4 %0, %1, off sc1" : "=v"(dst) : "v"(ptr) : "memory")
#pragma unroll
    for (int d0 = 0; d0 < 8; d0 += 2) { f32x4 t[2][4];
#pragma unroll
      for (int dd = 0; dd < 2; ++dd)
#pragma unroll
        for (int rq = 0; rq < 4; ++rq) LD4SC1(t[dd][rq], On + ((d0 + dd) * 4 + rq) * 64);
      asm volatile("s_waitcnt vmcnt(0)" : "+v"(t[0][0]), "+v"(t[0][1]), "+v"(t[0][2]), "+v"(t[0][3]), "+v"(t[1][0]), "+v"(t[1][1]), "+v"(t[1][2]), "+v"(t[1][3]) :: "memory");
#pragma unroll
      for (int dd = 0; dd < 2; ++dd)
#pragma unroll
        for (int rq = 0; rq < 4; ++rq)
#pragma unroll
          for (int i = 0; i < 4; ++i) { const float d = t[dd][rq][i] - lam * o[d0 + dd][4 * rq + i]; ssq[4 * rq + i] += d * d; } }
#pragma unroll
    for (int r = 0; r < 16; ++r) { float v = ssq[r];
      v = half_sum32(v);
      ssq[r] = 1.0f / sqrtf(v * (1.f / 256.f) + 1e-6f); }
    unsigned short* Aw = AOb + (long)(wid * QBLK + 4 * hi) * 2048 + r32;
#pragma unroll
    for (int d0 = 0; d0 < 8; d0 += 2) { f32x4 t[2][4];
#pragma unroll
      for (int dd = 0; dd < 2; ++dd)
#pragma unroll
        for (int rq = 0; rq < 4; ++rq) LD4SC1(t[dd][rq], On + ((d0 + dd) * 4 + rq) * 64);
      asm volatile("s_waitcnt vmcnt(0)" : "+v"(t[0][0]), "+v"(t[0][1]), "+v"(t[0][2]), "+v"(t[0][3]), "+v"(t[1][0]), "+v"(t[1][1]), "+v"(t[1][2]), "+v"(t[1][3]) :: "memory");
#pragma unroll
      for (int dd = 0; dd < 2; ++dd) { const float gl = gain[(d0 + dd) * 32 + r32] * gmul;
#pragma unroll
        for (int rq = 0; rq < 4; ++rq)
#pragma unroll
          for (int i = 0; i < 4; ++i) { const int r = 4 * rq + i;
            Aw[(long)(i + 8 * rq) * 2048 + (d0 + dd) * 32] = (unsigned short)(cvtpk((t[dd][rq][i] - lam * o[d0 + dd][r]) * ssq[r] * gl, 0.f) & 0xffffu); } } }
#undef LD4SC1
  }
  WAIT_BAR0();
#undef DMA_TILE
#undef LDSP
#undef RESC8
}
#undef WAIT_BAR0
#undef KSWZ
#undef SBAR
}

constexpr size_t MiB = 1u << 20;
constexpr size_t WS_CTL = 0, CTL_ZERO_BYTES = 64 * 1024;
constexpr size_t WS_MOD = 1 * MiB;
constexpr size_t WS_ROPE = 2 * MiB;
constexpr size_t WS_WQKV = 4 * MiB;
constexpr size_t WS_WO = WS_WQKV + 48 * MiB;
constexpr size_t WS_WIN = WS_WO + 16 * MiB;
constexpr size_t WS_WOUT = WS_WIN + 48 * MiB;
constexpr size_t WS_WUP = WS_WOUT + 16 * MiB;
constexpr size_t WS_WDN = WS_WUP + 176 * MiB;
constexpr size_t WS_X = WS_WDN + 88 * MiB;
constexpr size_t WS_H = WS_X + 132 * MiB;
constexpr size_t WS_C = WS_H + 66 * MiB;
constexpr size_t WS_QKV = WS_C;
constexpr size_t WS_OP = WS_C + 198 * MiB;
constexpr size_t WS_KT = WS_OP + 132 * MiB;
constexpr size_t WS_VT = WS_KT + 66 * MiB;
constexpr size_t WS_Y = WS_C;
constexpr size_t WS_ACT = WS_C + 363 * MiB;
constexpr size_t WS_YE = WS_ACT + 182 * MiB;
constexpr size_t WS_SLAB = WS_YE + 12 * MiB;
constexpr size_t WS_PE = WS_SLAB + 16 * MiB;
constexpr size_t WS_END = WS_PE + 4 * MiB;
static_assert((size_t)R * UPW * 2 <= 363 * MiB && (size_t)R * DFF * 2 <= 182 * MiB && (size_t)R * 4096 * 4 <= 264 * MiB && (size_t)R * QKVW * 2 <= 198 * MiB, "ws map");
static_assert(WS_OP + 264 * MiB <= WS_END, "ws map");

constexpr int CW_BAR = 1024;

constexpr int RING_BYTES = 131072;
constexpr int LDS_BYTES = 147456;
constexpr int MISC_OFF = 146432;

#define GAS __attribute__((address_space(1)))
#define LAS __attribute__((address_space(3)))
typedef unsigned short bf16r;
typedef unsigned v4u __attribute__((ext_vector_type(4)));
typedef unsigned v2u __attribute__((ext_vector_type(2)));
typedef float f32x4 __attribute__((ext_vector_type(4)));
typedef GAS unsigned gu32;
#define RLX_AGENT __ATOMIC_RELAXED, __HIP_MEMORY_SCOPE_AGENT
__device__ __forceinline__ unsigned pk2(float lo, float hi) { unsigned r; asm volatile("v_cvt_pk_bf16_f32 %0, %1, %2" : "=v"(r) : "v"(lo), "v"(hi)); return r; }
__device__ __forceinline__ float bf_lo(unsigned w) { return __uint_as_float(w << 16); }
__device__ __forceinline__ float bf_hi(unsigned w) { return __uint_as_float(w & 0xffff0000u); }
__device__ __forceinline__ float wave_sum(float v) {
    v = half_sum32(v);
    const auto rr = __builtin_amdgcn_permlane32_swap(__float_as_uint(v), __float_as_uint(v), false, false);
    return __uint_as_float(rr[0]) + __uint_as_float(rr[1]);
}

#define XB_TMO      128
#define XB_XCNT(j)  (256  + 64 * (j))
#define XB_XSUB(j)  (1280 + 64 * (j))
#define XB_XGEN(j)  (2304 + 64 * (j))
#define XB_TOP      3328
#define XB_TOPGEN   3392
#define XCD_BAR_WORDS 3456
#define XB_SPIN_CAP (1u << 18)
__device__ __forceinline__ unsigned xb_ld(unsigned* p)              { return __hip_atomic_load(p, __ATOMIC_RELAXED, __HIP_MEMORY_SCOPE_AGENT); }
__device__ __forceinline__ unsigned xb_add(unsigned* p, unsigned v) { return __hip_atomic_fetch_add(p, v, __ATOMIC_RELAXED, __HIP_MEMORY_SCOPE_AGENT); }
__device__ __forceinline__ unsigned xb_xcc_id() { return (unsigned)__builtin_amdgcn_s_getreg((3 << 11) | 20) & 0xFu; }
#define XB_SPIN(cond, bar) do { unsigned _sp = 0; while (cond) { __builtin_amdgcn_s_sleep(1); \
    if ((++_sp & 255u) == 0u) { if (xb_ld(&(bar)[XB_TMO])) break; if (_sp > XB_SPIN_CAP) { atomicAdd(&(bar)[XB_TMO], 1u); break; } } } } while (0)
struct XcdBarrier { unsigned* bar; unsigned x; volatile LAS unsigned* st; };
__device__ __forceinline__ XcdBarrier xcd_barrier_post(unsigned* bar, volatile LAS unsigned* st) {
    XcdBarrier b; b.bar = bar; b.x = xb_xcc_id(); b.st = st;
    if (threadIdx.x == 0) (void)xb_add(&bar[XB_XCNT(b.x)], 1u);
    return b;
}
__device__ __forceinline__ void xcd_barrier_complete(unsigned* bar, unsigned x, unsigned& nloc, unsigned& nx) {
    const unsigned G = gridDim.x * gridDim.y * gridDim.z;
    unsigned sum, cnt, mine, sp = 0u;
    for (;;) {
        sum = 0u; cnt = 0u; mine = 0u;
#pragma unroll
        for (unsigned j = 0; j < 16; ++j) { const unsigned c = xb_ld(&bar[XB_XCNT(j)]); sum += c; cnt += (c > 0u) ? 1u : 0u; }
        if (sum == G) { mine = xb_ld(&bar[XB_XCNT(x)]); break; }
        __builtin_amdgcn_s_sleep(1);
        if ((++sp & 255u) == 0u) { if (xb_ld(&bar[XB_TMO])) break; if (sp > XB_SPIN_CAP) { atomicAdd(&bar[XB_TMO], 1u); break; } }
    }
    nloc = mine > 0u ? mine : 1u; nx = cnt > 0u ? cnt : 1u;
}
__device__ __forceinline__ void xcd_barrier(const XcdBarrier& b) {
    asm volatile("s_waitcnt vmcnt(0)" ::: "memory");
    __syncthreads();
    if (threadIdx.x == 0) {
        unsigned* bar = b.bar; unsigned bx = b.x;
        asm volatile("" : "+s"(bx));
        __builtin_amdgcn_s_waitcnt(0);
        unsigned nloc = b.st[0], nx = b.st[1];
        if (nloc == 0u) { xcd_barrier_complete(bar, bx, nloc, nx); b.st[0] = nloc; b.st[1] = nx; }
        const unsigned old = xb_add(&bar[XB_XSUB(bx)], 1u);
        const unsigned gen = old / nloc;
        if (old + 1u == (gen + 1u) * nloc) {
            __builtin_amdgcn_fence(__ATOMIC_RELEASE, "agent");
            asm volatile("s_waitcnt vmcnt(0)" ::: "memory");
            const unsigned og = xb_add(&bar[XB_TOP], 1u);
            const unsigned tg = og / nx;
            if (og + 1u == (tg + 1u) * nx) xb_add(&bar[XB_TOPGEN], 1u);
            else XB_SPIN(xb_ld(&bar[XB_TOPGEN]) == tg, bar);
            __builtin_amdgcn_fence(__ATOMIC_ACQUIRE, "agent");
            xb_add(&bar[XB_XGEN(bx)], 1u);
            asm volatile("s_waitcnt vmcnt(0)" ::: "memory");
        } else {
            XB_SPIN(xb_ld(&bar[XB_XGEN(bx)]) == gen, bar);
            __builtin_amdgcn_fence(__ATOMIC_ACQUIRE, "agent");
            asm volatile("s_waitcnt vmcnt(0)" ::: "memory");
        }
    }
    __syncthreads();
}

struct Args { const float* in[20]; float* out; unsigned char* ws; int ph_lo, ph_hi; };
struct Frame {
    LAS unsigned char* lds;
    int wid0;
    int tid, lane, wave;
    int vcu, G;
    const Args* a;
    unsigned char* ws;
};
#define REFRESH(F) do { (F).tid = opaque_tid((F).wid0); (F).lane = (F).tid & 63; (F).wave = __builtin_amdgcn_readfirstlane((F).tid >> 6); } while (0)
#define FIN(k) (F.a->in[k])
#define F_x FIN(0)
#define F_c FIN(1)
#define F_ctx FIN(2)
#define F_c_ctx FIN(3)
#define F_w_ada FIN(4)
#define F_b_ada FIN(5)
#define F_w_qkv FIN(6)
#define F_w_o FIN(7)
#define F_lq1 FIN(8)
#define F_lk1 FIN(9)
#define F_lq2 FIN(10)
#define F_lk2 FIN(11)
#define F_subln FIN(12)
#define F_w_in FIN(13)
#define F_sconv FIN(14)
#define F_w_out FIN(15)
#define F_w_up FIN(16)
#define F_fconv FIN(17)
#define F_w_dn FIN(18)
#define F_fgain FIN(19)
#define F_out (F.a->out)
#define F_MOD ((float*)(F.ws + WS_MOD))
#define F_ROPE ((float*)(F.ws + WS_ROPE))
#define F_X ((float*)(F.ws + WS_X))
#define F_OP ((float*)(F.ws + WS_OP))
#define F_KT ((bf16r*)(F.ws + WS_KT))
#define F_VT ((bf16r*)(F.ws + WS_VT))
#define F_WQKV ((bf16r*)(F.ws + WS_WQKV))
#define F_WO ((bf16r*)(F.ws + WS_WO))
#define F_WIN ((bf16r*)(F.ws + WS_WIN))
#define F_WOUT ((bf16r*)(F.ws + WS_WOUT))
#define F_WUP ((bf16r*)(F.ws + WS_WUP))
#define F_WDN ((bf16r*)(F.ws + WS_WDN))
#define F_H ((bf16r*)(F.ws + WS_H))
#define F_QKV ((bf16r*)(F.ws + WS_QKV))
#define F_Y ((bf16r*)(F.ws + WS_Y))
#define F_ACT ((bf16r*)(F.ws + WS_ACT))
#define F_YE ((float*)(F.ws + WS_YE))
#define F_SLAB ((float*)(F.ws + WS_C))
#define F_PE ((float*)(F.ws + WS_PE))
#define F_YS ((float*)(F.ws + WS_C))
#define F_XST ((float*)(F.ws + WS_PE + 3 * MiB))
#define F_GB ((bf16r*)(F.ws + WS_QKV))
#define F_CZ ((bf16r*)(F.ws + WS_QKV + 66 * MiB))

__device__ __forceinline__ unsigned pk4f8(float a, float b, float c, float d) { int w = __builtin_amdgcn_cvt_pk_fp8_f32(a, b, 0, false); w = __builtin_amdgcn_cvt_pk_fp8_f32(c, d, w, true); return (unsigned)w; }
__device__ __forceinline__ void p0_transpose_item(const float* W, int K, int N, bf16r* WT, int permk, LAS float* scr, int item, int lane, bool fp8out = false) {
    const int nblk = N / 64, kb = item / nblk, nb = item % nblk, k0 = 64 * kb, n0 = 64 * nb;
    const float* src = W + (size_t)(k0 + (lane >> 4)) * N + n0 + 4 * (lane & 15);
    LAS float* sdst = scr + (lane >> 4) * 65 + 4 * (lane & 15);
#pragma unroll
    for (int h = 0; h < 2; ++h) { f32x4 v[8];
#pragma unroll
        for (int i = 0; i < 8; ++i) v[i] = *(const GAS f32x4*)(src + (size_t)(4 * (8 * h + i)) * N);
#pragma unroll
        for (int i = 0; i < 8; ++i) { LAS float* d = sdst + 4 * (8 * h + i) * 65; d[0] = v[i].x; d[1] = v[i].y; d[2] = v[i].z; d[3] = v[i].w; } }
    asm volatile("s_waitcnt lgkmcnt(0)" ::: "memory");
    const int c = lane & 7;
    const bool il = (permk == 1) && (n0 < 4096);
    int db = n0;
    if (permk == 2) { const bool isv = n0 >= DFF; const int c0 = isv ? n0 - DFF : n0; db = (c0 >> 7) * 256 + (c0 & 127) + (isv ? 128 : 0); }
    if (permk == 3) { if (n0 < DM) db = 2 * DM + n0; else { const bool isx = n0 >= 2 * DM; const int c0 = n0 - (isx ? 2 * DM : DM); db = (c0 >> 7) * 256 + (c0 & 127) + (isx ? 128 : 0); } }
#pragma unroll
    for (int j = 0; j < 8; ++j) { const int n = (lane >> 3) + 8 * j; const LAS float* s = scr + (8 * c) * 65 + n;
        v4u o; o.x = pk2(s[0 * 65], s[1 * 65]); o.y = pk2(s[2 * 65], s[3 * 65]); o.z = pk2(s[4 * 65], s[5 * 65]); o.w = pk2(s[6 * 65], s[7 * 65]);
        const int nd = il ? (2 * (n & 31) + (n >> 5)) : n;
        if (fp8out) { constexpr float WS = 64.f;
            v2u o8; o8.x = pk4f8(WS * s[0 * 65], WS * s[1 * 65], WS * s[2 * 65], WS * s[3 * 65]); o8.y = pk4f8(WS * s[4 * 65], WS * s[5 * 65], WS * s[6 * 65], WS * s[7 * 65]);
            *(GAS v2u*)((unsigned char*)WT + (size_t)(db + nd) * K + k0 + 8 * c) = o8;
            if (permk == 1 && n0 >= 4096) {
                float r[8];
#pragma unroll
                for (int q = 0; q < 8; ++q) r[q] = WS * s[q * 65] - __builtin_amdgcn_cvt_f32_fp8((int)((q < 4 ? o8.x : o8.y) >> (8 * (q & 3))), 0);
                v2u l8; l8.x = pk4f8(r[0], r[1], r[2], r[3]); l8.y = pk4f8(r[4], r[5], r[6], r[7]);
                *(GAS v2u*)((unsigned char*)WT + (size_t)(db + nd + 2048) * K + k0 + 8 * c) = l8; } }
        else *(GAS v4u*)(WT + (size_t)(db + nd) * K + k0 + 8 * c) = o; }
    asm volatile("s_waitcnt lgkmcnt(0)" ::: "memory");
}
typedef float f32x3u __attribute__((ext_vector_type(3), aligned(4)));
__device__ __forceinline__ void p0_prologue(Frame& F) {
    REFRESH(F);
    {
        LAS float* ssl = (LAS float*)F.lds;
        LAS float* red = (LAS float*)(F.lds + 24576);
        for (int idx = F.tid; idx < 3 * DM; idx += NWAVES * 64) { const int set = idx / DM, k = idx % DM; const float v = (set < 2) ? F_c[set * DM + k] : F_c_ctx[k]; ssl[idx] = v / (1.f + __expf(-v)); }
        __syncthreads();
        for (int item = blockIdx.x; item < 256; item += F.G) {
            const int layer = item >> 6, chunk = item & 63, n0 = chunk * 192;
            const float* Wp = F_w_ada + (size_t)layer * DM * NMODW + n0 + 3 * F.lane;
            float acc[3][3];
#pragma unroll
            for (int s = 0; s < 3; ++s)
#pragma unroll
                for (int j = 0; j < 3; ++j) acc[s][j] = 0.f;
            const int kbeg = F.wave * 256;
            for (int k = kbeg; k < kbeg + 256; k += 8) {
                f32x3u w[8];
#pragma unroll
                for (int q = 0; q < 8; ++q) w[q] = *(const f32x3u*)(Wp + (size_t)(k + q) * NMODW);
#pragma unroll
                for (int q = 0; q < 8; ++q) { const float s0 = ssl[k + q], s1 = ssl[DM + k + q], s2 = ssl[2 * DM + k + q];
#pragma unroll
                    for (int j = 0; j < 3; ++j) { acc[0][j] += s0 * w[q][j]; acc[1][j] += s1 * w[q][j]; acc[2][j] += s2 * w[q][j]; } }
            }
#pragma unroll
            for (int s = 0; s < 3; ++s)
#pragma unroll
                for (int j = 0; j < 3; ++j) red[(F.wave * 9 + s * 3 + j) * 64 + F.lane] = acc[s][j];
            __syncthreads();
            for (int idx = F.tid; idx < 9 * 64; idx += NWAVES * 64) { const int q = idx >> 6, l = idx & 63, set = q / 3, j = q % 3; float sum = 0.f;
#pragma unroll
                for (int w = 0; w < 8; ++w) sum += red[(w * 9 + q) * 64 + l];
                const int col = n0 + 3 * l + j;
                F_MOD[(size_t)(layer * 3 + set) * NMODW + col] = sum + F_b_ada[layer * NMODW + col]; }
            __syncthreads();
        }
    }
    const int gw = F.vcu * NWAVES + F.wave, NGW = F.G * NWAVES;
    {
        LAS float* scr = (LAS float*)(F.lds + F.wave * 16640);
        constexpr int I_QKV = 32 * 96, I_SQ = 32 * 32, I_UP = 32 * 176, I_DN = 88 * 32;
        constexpr int E0 = 2 * I_QKV, E1 = E0 + 2 * I_SQ, E2 = E1 + 2 * I_QKV, E3 = E2 + 2 * I_SQ, E4 = E3 + 4 * I_UP, E5 = E4 + 4 * I_DN;
        for (int it = gw; it < E5; it += NGW) {
            if (it < E0) { const int m = it / I_QKV, r = it % I_QKV; p0_transpose_item(F_w_qkv + (size_t)m * DM * QKVW, DM, QKVW, (bf16r*)((unsigned char*)F_WQKV + (size_t)m * 8192 * DM), 1, scr, r, F.lane, true);   }
            else if (it < E1) { const int q = it - E0, m = q / I_SQ, r = q % I_SQ; p0_transpose_item(F_w_o + (size_t)m * DM * DM, DM, DM, F_WO + (size_t)m * DM * DM, 0, scr, r, F.lane); }
            else if (it < E2) { const int q = it - E1, m = q / I_QKV, r = q % I_QKV; p0_transpose_item(F_w_in + (size_t)m * DM * QKVW, DM, QKVW, F_WIN + (size_t)m * QKVW * DM, 3, scr, r, F.lane); }
            else if (it < E3) { const int q = it - E2, m = q / I_SQ, r = q % I_SQ; p0_transpose_item(F_w_out + (size_t)m * DM * DM, DM, DM, F_WOUT + (size_t)m * DM * DM, 0, scr, r, F.lane); }
            else if (it < E4) { const int q = it - E3, m = q / I_UP, r = q % I_UP; p0_transpose_item(F_w_up + (size_t)m * DM * UPW, DM, UPW, F_WUP + (size_t)m * UPW * DM, 2, scr, r, F.lane); }
            else { const int q = it - E4, m = q / I_DN, r = q % I_DN; p0_transpose_item(F_w_dn + (size_t)m * DFF * DM, DFF, DM, F_WDN + (size_t)m * DM * DFF, 0, scr, r, F.lane); }
        }
    }
    {
        const int gt = gw * 64 + F.lane;
        if (gt < 128 * 32) { const int pos = gt >> 5, f = gt & 31; const float angf = (float)pos * INV_FREQ[f]; const double a = (double)angf;
            const double TWO_PI = 6.283185307179586476925286766559; double r = a - TWO_PI * __builtin_rint(a / TWO_PI);
            const double r2 = r * r; double sn = 0.0, cs = 0.0;
            double ts = r, tc = 1.0;
#pragma unroll 1
            for (int i = 0; i < 14; ++i) { cs += tc; sn += ts; tc = -tc * r2 / (double)((2 * i + 1) * (2 * i + 2)); ts = -ts * r2 / (double)((2 * i + 2) * (2 * i + 3)); }
            F_ROPE[2 * gt] = (float)cs; F_ROPE[2 * gt + 1] = (float)sn; }
    }
}

__device__ __forceinline__ const float* norm_src(Frame& F, int u, bool from_input) {
    if (from_input) { const int b = u / ROWS_B, w = u % ROWS_B; return (w < SEQ) ? F_x + (size_t)(b * SEQ + w) * DM : F_ctx + (size_t)(b * CTXL + (w - SEQ)) * DM; }
    return F_X + (size_t)u * DM;
}
__device__ __forceinline__ void norm_mod_phase(Frame& F, int layer, int which, bool skip_ctx, bool from_input = false, int nslab = 0, bool ctx_from_input = false, bool fp8out = false) {
    REFRESH(F);
    const int gw = F.vcu * NWAVES + F.wave, NGW = F.G * NWAVES;
    f32x4 v[8], vn[8];
    if (gw < R) { const GAS f32x4* xr = (const GAS f32x4*)norm_src(F, gw, from_input || (ctx_from_input && (gw % ROWS_B) >= SEQ)) + F.lane;
#pragma unroll
        for (int j = 0; j < 8; ++j) v[j] = xr[64 * j]; }
    for (int u = gw; u < R; u += NGW) {
        const int un = u + NGW;
        if (un < R) { const GAS f32x4* xr = (const GAS f32x4*)norm_src(F, un, from_input || (ctx_from_input && (un % ROWS_B) >= SEQ)) + F.lane;
#pragma unroll
            for (int j = 0; j < 8; ++j) vn[j] = xr[64 * j]; }
        const int pan = u >> 8, pp = pan % PAN_B;
        if (!(skip_ctx && pp == 32)) {
            const int set = (pp == 32) ? 2 : pan / PAN_B;
            const float* sh = F_MOD + (size_t)(layer * 3 + set) * NMODW + (which ? 3 : 0) * DM; const float* sc = sh + DM;
            float ss = 0.f;
            if (nslab > 0 && pp == 32) {
                const int cr = (pan / PAN_B) * 256 + (u & 255);
                for (int k = 0; k < nslab; ++k) { const GAS f32x4* sp = (const GAS f32x4*)(F_SLAB + ((size_t)k * 512 + cr) * DM) + F.lane;
#pragma unroll
                    for (int j = 0; j < 8; ++j) v[j] += sp[64 * j]; }
                GAS f32x4* xw = (GAS f32x4*)(F_X + (size_t)u * DM) + F.lane;
#pragma unroll
                for (int j = 0; j < 8; ++j) xw[64 * j] = v[j]; }
#pragma unroll
            for (int j = 0; j < 8; ++j) ss += (v[j].x * v[j].x + v[j].y * v[j].y) + (v[j].z * v[j].z + v[j].w * v[j].w);
            const float rstd = 1.0f / sqrtf(wave_sum(ss) * (1.f / DM) + EPS);
            GAS v2u* o8 = (GAS v2u*)(F_H + (size_t)u * DM) + F.lane; GAS unsigned* o4 = (GAS unsigned*)((unsigned char*)F_H + (size_t)u * DM) + F.lane;
#pragma unroll
            for (int j = 0; j < 8; ++j) { const f32x4 s4 = *((const f32x4*)sc + F.lane + 64 * j), h4 = *((const f32x4*)sh + F.lane + 64 * j);
                const f32x4 y = (v[j] * rstd) * (s4 + 1.0f) + h4;
                if (fp8out) o4[64 * j] = pk4f8(y.x, y.y, y.z, y.w);
                else { v2u w; w.x = pk2(y.x, y.y); w.y = pk2(y.z, y.w); o8[64 * j] = w; } }
        }
#pragma unroll
        for (int j = 0; j < 8; ++j) v[j] = vn[j];
    }
}
__device__ __forceinline__ void norm_ctx_phase(Frame& F, int layer, int which, bool ctx_from_input, bool fp8out) {
    REFRESH(F);
    const int gw = F.vcu * NWAVES + F.wave, NGW = F.G * NWAVES;
    const float* sh = F_MOD + (size_t)(layer * 3 + 2) * NMODW + (which ? 3 : 0) * DM; const float* sc = sh + DM;
    for (int i = gw; i < NBATCH * CTXL; i += NGW) {
        const int b = i / CTXL, r = i % CTXL; const size_t u = (size_t)b * ROWS_B + SEQ + r;
        const GAS f32x4* xr = (const GAS f32x4*)(ctx_from_input ? F_ctx + (size_t)i * DM : F_X + u * DM) + F.lane;
        f32x4 v[8];
#pragma unroll
        for (int j = 0; j < 8; ++j) v[j] = xr[64 * j];
        const int nslab = which ? 4 : 11;
        for (int k = 0; k < nslab; k += 4) { f32x4 t[4][8];
#pragma unroll
            for (int b = 0; b < 4; ++b) { const int kk = (k + b < nslab) ? k + b : k; const GAS f32x4* sp = (const GAS f32x4*)(F_SLAB + ((size_t)kk * 512 + i) * DM) + F.lane;
#pragma unroll
                for (int j = 0; j < 8; ++j) t[b][j] = sp[64 * j]; }
#pragma unroll
            for (int b = 0; b < 4; ++b) if (k + b < nslab) {
#pragma unroll
                for (int j = 0; j < 8; ++j) v[j] += t[b][j]; } }
        GAS f32x4* xw = (GAS f32x4*)(F_X + u * DM) + F.lane; float ss = 0.f;
#pragma unroll
        for (int j = 0; j < 8; ++j) { xw[64 * j] = v[j]; ss += (v[j].x * v[j].x + v[j].y * v[j].y) + (v[j].z * v[j].z + v[j].w * v[j].w); }
        const float rstd = 1.0f / sqrtf(wave_sum(ss) * (1.f / DM) + EPS);
        GAS v2u* o8 = (GAS v2u*)(F_H + u * DM) + F.lane; GAS unsigned* o4 = (GAS unsigned*)((unsigned char*)F_H + u * DM) + F.lane;
        f32x4 s4[8], h4[8];
#pragma unroll
        for (int j = 0; j < 8; ++j) { s4[j] = *((const f32x4*)sc + F.lane + 64 * j); h4[j] = *((const f32x4*)sh + F.lane + 64 * j); }
#pragma unroll
        for (int j = 0; j < 8; ++j) { const f32x4 y = (v[j] * rstd) * (s4[j] + 1.0f) + h4[j];
            if (fp8out) o4[64 * j] = pk4f8(y.x, y.y, y.z, y.w);
            else { v2u w; w.x = pk2(y.x, y.y); w.y = pk2(y.z, y.w); o8[64 * j] = w; } }
    }
}
__device__ __forceinline__ void final_phase(Frame& F) {
    REFRESH(F);
    const int gw = F.vcu * NWAVES + F.wave, NGW = F.G * NWAVES;
    for (int m = gw; m < NBATCH * SEQ; m += NGW) {
        const int b = m / SEQ, t = m % SEQ; const size_t u = (size_t)b * ROWS_B + t;
        const GAS f32x4* xr = (const GAS f32x4*)(F_X + u * DM) + F.lane;
        f32x4 v[8]; float ss = 0.f;
#pragma unroll
        for (int j = 0; j < 8; ++j) { v[j] = xr[64 * j]; ss += (v[j].x * v[j].x + v[j].y * v[j].y) + (v[j].z * v[j].z + v[j].w * v[j].w); }
        const float rstd = 1.0f / sqrtf(wave_sum(ss) * (1.f / DM) + EPS);
        GAS f32x4* o = (GAS f32x4*)(F_out + (size_t)m * DM) + F.lane;
#pragma unroll
        for (int j = 0; j < 8; ++j) { const f32x4 g4 = *((const f32x4*)F_fgain + F.lane + 64 * j); o[64 * j] = (v[j] * rstd) * g4; }
    }
}
__device__ __forceinline__ bool seq_first(int u) { const int w = u % ROWS_B; return w == 0 || w == SEQ; }
__device__ __forceinline__ bool seq_last(int u) { const int w = u % ROWS_B; return w == SEQ - 1 || w == ROWS_B - 1; }
__device__ __forceinline__ void ffn_fix_phase(Frame& F, int layer, bool skip_ctx) {
    REFRESH(F);
    const int gw = F.vcu * NWAVES + F.wave, NGW = F.G * NWAVES;
    constexpr int NCC = DFF / 512;
    const float* cw = F_fconv + (size_t)layer * 3 * UPW;
    for (int it = gw; it < NPAN * 2 * NCC; it += NGW) {
        const int cc = it % NCC, pe = it / NCC, edge = pe & 1, pm = pe >> 1;
        if ((pm % PAN_B) == 32) continue;
        const int row = pm * 256 + (edge ? 255 : 0), c0 = cc * 512 + F.lane * 8, yc = (c0 >> 7) * 256 + (c0 & 127);
        const float* ya; const float* yb; const float* yc_; bool za = false, zc = false;
        if (edge == 0) { za = seq_first(row); ya = F_YE + (size_t)((pm - 1) * 4 + 3) * UPW; yb = F_YE + (size_t)(pm * 4 + 0) * UPW; yc_ = F_YE + (size_t)(pm * 4 + 1) * UPW; }
        else { zc = seq_last(row); ya = F_YE + (size_t)(pm * 4 + 2) * UPW; yb = F_YE + (size_t)(pm * 4 + 3) * UPW; yc_ = F_YE + (size_t)((pm + 1) * 4 + 0) * UPW; }
        v4u o;
#pragma unroll
        for (int h = 0; h < 2; ++h) { f32x4 r[2];
#pragma unroll
            for (int bj = 0; bj < 2; ++bj) { const int yo = yc + bj * 128 + 4 * h;
                const f32x4 a = za ? (f32x4){0.f, 0.f, 0.f, 0.f} : *(const f32x4*)(ya + yo), b = *(const f32x4*)(yb + yo), c = zc ? (f32x4){0.f, 0.f, 0.f, 0.f} : *(const f32x4*)(yc_ + yo);
                const float* wp = cw + bj * DFF + c0 + 4 * h;
                r[bj] = *(const f32x4*)(wp) * a + *(const f32x4*)(wp + UPW) * b + *(const f32x4*)(wp + 2 * UPW) * c; }
            float t[4];
#pragma unroll
            for (int e = 0; e < 4; ++e) { const float g = r[0][e]; t[e] = g / (1.f + __expf(-g)) * r[1][e]; }
            o[2 * h] = pk2(t[0], t[1]); o[2 * h + 1] = pk2(t[2], t[3]); }
        *(GAS v4u*)(F_ACT + (size_t)row * DFF + c0) = o;
    }
    if (!skip_ctx) {
        const float* Y0 = F_YS; const float* Y1 = F_YS + (size_t)512 * UPW;
        for (int it = gw; it < 128 * NCC; it += NGW) {
            const int cc = it % NCC, sg = it / NCC, cr0 = sg * 4, r0 = cr0 & 255;
            const int c0 = cc * 512 + F.lane * 8, yc = (c0 >> 7) * 256 + (c0 & 127);
            f32x4 wv[3][2][2];
#pragma unroll
            for (int j = 0; j < 3; ++j)
#pragma unroll
                for (int bj = 0; bj < 2; ++bj)
#pragma unroll
                    for (int h = 0; h < 2; ++h) wv[j][bj][h] = *(const f32x4*)(cw + (size_t)j * UPW + bj * DFF + c0 + 4 * h);
            f32x4 ya[2][2], yb[2][2], yn[2][2];
#define LDROW(dst, cr_) do { const size_t o_ = (size_t)(cr_) * UPW + yc; \
                _Pragma("unroll") for (int bj = 0; bj < 2; ++bj) _Pragma("unroll") for (int h = 0; h < 2; ++h) dst[bj][h] = *(const f32x4*)(Y0 + o_ + bj * 128 + 4 * h) + *(const f32x4*)(Y1 + o_ + bj * 128 + 4 * h); } while (0)
#pragma unroll
            for (int bj = 0; bj < 2; ++bj)
#pragma unroll
                for (int h = 0; h < 2; ++h) ya[bj][h] = (f32x4){0.f, 0.f, 0.f, 0.f};
            if (r0 > 0) LDROW(ya, cr0 - 1);
            LDROW(yb, cr0);
#pragma unroll 1
            for (int k = 0; k < 4; ++k) { const int r = r0 + k;
#pragma unroll
                for (int bj = 0; bj < 2; ++bj)
#pragma unroll
                    for (int h = 0; h < 2; ++h) yn[bj][h] = (f32x4){0.f, 0.f, 0.f, 0.f};
                if (r < 255) LDROW(yn, cr0 + k + 1);
                v4u o;
#pragma unroll
                for (int h = 0; h < 2; ++h) { const f32x4 g4 = wv[0][0][h] * ya[0][h] + wv[1][0][h] * yb[0][h] + wv[2][0][h] * yn[0][h], v4 = wv[0][1][h] * ya[1][h] + wv[1][1][h] * yb[1][h] + wv[2][1][h] * yn[1][h];
                    float t[4];
#pragma unroll
                    for (int e = 0; e < 4; ++e) t[e] = g4[e] / (1.f + __expf(-g4[e])) * v4[e];
                    o[2 * h] = pk2(t[0], t[1]); o[2 * h + 1] = pk2(t[2], t[3]); }
                *(GAS v4u*)(F_ACT + ((size_t)((cr0 + k) >> 8) * ROWS_B + SEQ + r) * DFF + c0) = o;
#pragma unroll
                for (int bj = 0; bj < 2; ++bj)
#pragma unroll
                    for (int h = 0; h < 2; ++h) { ya[bj][h] = yb[bj][h]; yb[bj][h] = yn[bj][h]; } }
#undef LDROW
        }
    }
}
__device__ __forceinline__ void sconv_gate_phase(Frame& F, int j, bool skip_ctx) {
    REFRESH(F);
    const int gw = F.vcu * NWAVES + F.wave, NGW = F.G * NWAVES;
    constexpr int NCC = DM / 512, NRC = R / 8;
    const float* cw = F_sconv + (size_t)j * 3 * DM;
    for (int it = gw; it < NRC * NCC; it += NGW) {
        const int cc = it % NCC, rc = it / NCC, u0 = rc * 8, c0 = cc * 512 + F.lane * 8;
        const int pm = u0 >> 8; if (skip_ctx && (pm % PAN_B) == 32) continue;
        v4u gb[8], cz[8];
#pragma unroll
        for (int q = 0; q < 8; ++q) { gb[q] = *(const GAS v4u*)(F_GB + (size_t)(u0 + q) * DM + c0); cz[q] = *(const GAS v4u*)(F_CZ + (size_t)(u0 + q) * DM + c0); }
        const int rin = u0 & 255;
        const bool e0 = (rin == 0), e1 = (rin == 248);
        float fx[8];
        if (e0 || e1) {
            const int row = e0 ? u0 : u0 + 7; const bool za = e0 && seq_first(row), zc = e1 && seq_last(row);
            const float* ya = e0 ? F_PE + (size_t)((pm - 1) * 4 + 3) * DM : F_PE + (size_t)(pm * 4 + 2) * DM;
            const float* yb = e0 ? F_PE + (size_t)(pm * 4 + 0) * DM : F_PE + (size_t)(pm * 4 + 3) * DM;
            const float* yc = e0 ? F_PE + (size_t)(pm * 4 + 1) * DM : F_PE + (size_t)((pm + 1) * 4 + 0) * DM;
#pragma unroll
            for (int h = 0; h < 2; ++h) { const int o = c0 + 4 * h;
                const f32x4 a = za ? (f32x4){0.f, 0.f, 0.f, 0.f} : *(const f32x4*)(ya + o), b = *(const f32x4*)(yb + o), c = zc ? (f32x4){0.f, 0.f, 0.f, 0.f} : *(const f32x4*)(yc + o);
                const f32x4 r = *(const f32x4*)(cw + o) * a + *(const f32x4*)(cw + DM + o) * b + *(const f32x4*)(cw + 2 * DM + o) * c;
                fx[4 * h] = r[0]; fx[4 * h + 1] = r[1]; fx[4 * h + 2] = r[2]; fx[4 * h + 3] = r[3]; } }
#pragma unroll
        for (int q = 0; q < 8; ++q) { v4u o; const bool edge = (q == 0 && e0) || (q == 7 && e1);
#pragma unroll
            for (int e = 0; e < 4; ++e) { const float ca = edge ? fx[2 * e] : bf_lo(cz[q][e]), cb2 = edge ? fx[2 * e + 1] : bf_hi(cz[q][e]);
                o[e] = pk2(bf_lo(gb[q][e]) * ca, bf_hi(gb[q][e]) * cb2); }
            *(GAS v4u*)(F_H + (size_t)(u0 + q) * DM + c0) = o; }
    }
}
__device__ __forceinline__ void attn_phase(Frame& F, bool with_ctx, int a, float lam_init, char* lds) {
    REFRESH(F);
    const int c = blockIdx.x; const int G = F.G;
    float d1 = 0.f, d2 = 0.f;
#pragma unroll
    for (int j = 0; j < 2; ++j) { const int e = F.lane + 64 * j; d1 += F_lq1[a * 128 + e] * F_lk1[a * 128 + e]; d2 += F_lq2[a * 128 + e] * F_lk2[a * 128 + e]; }
    d1 = wave_sum(d1); d2 = wave_sum(d2);
    const float lam = expf(d1) - expf(d2) + lam_init;
    const float* gain = F_subln + a * 256;
    const int nlat = 16 * 32, ntot = nlat + (with_ctx ? 16 : 0);
    for (int L = c; L < ntot; L += G) {
        int combo, qb, kstart, seq;
        if (L < nlat) { const int rnd = L / 256, idx = L % 256; combo = rnd * 8 + (idx & 7); qb = idx >> 3; kstart = 0; seq = ROWS_B; }
        else { combo = L - nlat; qb = 32; kstart = SEQ; seq = CTXL; }
        const int h = combo & 7, b = combo >> 3;
        const size_t rowq = (size_t)b * ROWS_B + (size_t)qb * 256; const int jstart = kstart >> 6;
        const unsigned char* Vh = (const unsigned char*)F_VT + ((size_t)(b * 8 + h) * 132 + jstart) * 16384;
        float* O1 = F_OP + (size_t)((b * 8 + h) * 33 + qb) * 65536;
        unsigned short* AO = (unsigned short*)F_H + rowq * DM + h * 256;
#pragma unroll 1
        for (int i = 0; i < 2; ++i) { const int hs = 2 * h + i;
            att::attn_unit_v256((const unsigned char*)F_QKV + rowq * DM + hs * 128, (const unsigned char*)F_KT + ((size_t)(b * 16 + hs) * 132 + jstart) * 8192, Vh, O1, seq, lds, i, O1, AO, lam, gain, 1.0f - lam_init, F.wid0); }
    }
}

constexpr int PH_PER_LAYER = 9, NPHASES = 1 + DEPTH * PH_PER_LAYER + 1;
__global__ void __launch_bounds__(NWAVES * 64, 2) trunk_fwd(Args args) {
    extern __shared__ __attribute__((aligned(16))) unsigned char lds[];
    Frame F;
    F.lds = (LAS unsigned char*)lds;
    F.wid0 = __builtin_amdgcn_readfirstlane((int)threadIdx.x >> 6);
    REFRESH(F);
    F.G = gridDim.x; { const int bx = blockIdx.x; F.vcu = (F.G % 8 == 0) ? (bx % 8) * (F.G / 8) + bx / 8 : bx; }
    unsigned char* ws = args.ws; F.ws = ws; F.a = &args;
    volatile LAS unsigned* MISC = (volatile LAS unsigned*)(F.lds + MISC_OFF);
    for (int u = F.tid; u < (LDS_BYTES - MISC_OFF) / 4; u += NWAVES * 64) MISC[u] = 0u;
    __syncthreads();
    const int lo = args.ph_lo, hi = args.ph_hi; (void)lo; (void)hi;
#if MK_PER_PHASE
    XcdBarrier bar; bar.bar = nullptr; bar.x = 0; bar.st = nullptr;
#define GRID_BAR() do { } while (0)
#else
    XcdBarrier bar = xcd_barrier_post((unsigned*)(ws + WS_CTL) + CW_BAR, MISC + 8);
#define GRID_BAR() xcd_barrier(bar)
#endif
#if MK_PER_PHASE
#define IN(k) (lo <= (k) && (k) < hi)
#else
#define IN(k) true
#endif
#define SEAM(k) do { if (IN(k) && IN((k) + 1)) GRID_BAR(); } while (0)

    if (IN(0)) { p0_prologue(F); }
    SEAM(0);

#pragma unroll 1
    for (int layer = 0; layer < DEPTH; ++layer) {
        const int pb = 1 + layer * PH_PER_LAYER;
        const bool ctx_update = layer < 2;
        const bool lat_only = !ctx_update;
        const int nMl = lat_only ? 64 : NPAN;
        if ((layer & 1) == 0) {
            const int a = layer >> 1;
            const float lam_init = (layer == 0) ? 0.2f : 0.4707130183435842f;
            if (layer == 0) norm_mod_phase(F, layer, 0, false, true, 0, false, true);
            else norm_ctx_phase(F, layer, 0, false, true);
            SEAM(pb + 0);
            if (IN(pb + 1)) { pg8::Gemm g{F_H, (const pg8::bf16_t*)((const unsigned char*)F_WQKV + (size_t)a * 8192 * DM), DM}; pg8::QkvOrder S{F.G, (int)blockIdx.x};
                pg8::EpiQKV E{(unsigned char*)F_QKV, F_ROPE, (unsigned char*)F_KT, (unsigned char*)F_VT, F.wid0};
                pg8::gemm_phase<pg8::EpiQKV, pg8::QkvOrder, true, true, true>(F.lds, g, S, E, F.wid0); }
            SEAM(pb + 1);

#ifndef NO_ATTN
            if (IN(pb + 2)) { attn_phase(F, ctx_update, a, lam_init, (char*)lds); __syncthreads(); }
#endif
            SEAM(pb + 2);
            if (IN(pb + 4)) { pg8::Gemm g{F_H, F_WO + (size_t)a * DM * DM, DM}; pg8::PanelOrder S; S.init(64, DM / 256, F.G, (int)blockIdx.x, 1, DM / 64, ctx_update ? 4 : 0);
                pg8::EpiResidualNorm E{F_X, F_MOD + (size_t)(layer * 3) * NMODW + 2 * DM, (layer == 0) ? F_x : nullptr, F_SLAB, (const float*)(F.ws + WS_CTL + 32768), F_MOD + (size_t)(layer * 3) * NMODW + 3 * DM, (void*)F_H, F_XST, (unsigned*)(F.ws + WS_CTL + 40960),
                    64u * (unsigned)(2 * layer + 1), (PG8_LAS float*)(F.lds + RING_BYTES), F.wid0, 1};
                pg8::gemm_phase<pg8::EpiResidualNorm, pg8::PanelOrder, true, true>(F.lds, g, S, E, F.wid0); }
            SEAM(pb + 4);
        } else {
            const int j = layer >> 1;
            if (layer == 1) { norm_ctx_phase(F, layer, 0, false, false); SEAM(pb + 0); }
            if (IN(pb + 1)) { pg8::Gemm g{F_H, F_WIN + (size_t)j * QKVW * DM, DM}; pg8::PanelOrder S; S.init(64, QKVW / 256, F.G, (int)blockIdx.x, 1, DM / 64, ctx_update ? 1 : 0);
                pg8::EpiSconv E{F_GB, F_CZ, F_PE, F_sconv + (size_t)j * 3 * DM, (PG8_LAS float*)(F.lds + RING_BYTES)};
                pg8::gemm_phase<pg8::EpiSconv, pg8::PanelOrder, true, true>(F.lds, g, S, E, F.wid0); }
            SEAM(pb + 1);
            if (IN(pb + 2)) sconv_gate_phase(F, j, lat_only);
            SEAM(pb + 2);
            if (IN(pb + 4)) { pg8::Gemm g{F_H, F_WOUT + (size_t)j * DM * DM, DM}; pg8::PanelOrder S; S.init(64, DM / 256, F.G, (int)blockIdx.x, 1, DM / 64, ctx_update ? 4 : 0);
                pg8::EpiResidualNorm E{F_X, F_MOD + (size_t)(layer * 3) * NMODW + 2 * DM, nullptr, F_SLAB, (const float*)(F.ws + WS_CTL + 32768), F_MOD + (size_t)(layer * 3) * NMODW + 3 * DM, (void*)F_H, F_XST, (unsigned*)(F.ws + WS_CTL + 40960),
                    64u * (unsigned)(2 * layer + 1), (PG8_LAS float*)(F.lds + RING_BYTES), F.wid0, 1};
                pg8::gemm_phase<pg8::EpiResidualNorm, pg8::PanelOrder, true, true>(F.lds, g, S, E, F.wid0); }
            SEAM(pb + 4);
        }
        if (ctx_update) { norm_ctx_phase(F, layer, 1, layer == 0, false); SEAM(pb + 5); }
        if (IN(pb + 6)) { pg8::Gemm g{F_H, F_WUP + (size_t)layer * UPW * DM, DM}; pg8::PanelOrder S; S.init(64, UPW / 256, F.G, (int)blockIdx.x, 1, DM / 64, ctx_update ? 2 : 0);
            pg8::EpiConvGate E{F_ACT, F_YE, F_fconv + (size_t)layer * 3 * UPW, (PG8_LAS float*)(F.lds + RING_BYTES), ctx_update ? F_YS : nullptr};
            pg8::gemm_phase<pg8::EpiConvGate, pg8::PanelOrder, true, true>(F.lds, g, S, E, F.wid0); }
        SEAM(pb + 6);
        if (IN(pb + 7)) ffn_fix_phase(F, layer, lat_only);
        SEAM(pb + 7);
        if (IN(pb + 8)) { pg8::Gemm g{F_ACT, F_WDN + (size_t)layer * DM * DFF, DFF}; pg8::PanelOrder S; S.init(64, DM / 256, F.G, (int)blockIdx.x, 1, DFF / 64, ctx_update ? 11 : 0);
            const bool fin = (layer == DEPTH - 1);
            pg8::EpiResidualNorm E{F_X, F_MOD + (size_t)(layer * 3) * NMODW + 5 * DM, nullptr, F_SLAB, (const float*)(F.ws + WS_CTL + 32768), fin ? F_fgain : F_MOD + (size_t)((layer + 1) * 3) * NMODW, fin ? (void*)F_out : (void*)F_H, F_XST, (unsigned*)(F.ws + WS_CTL + 40960),
                64u * (unsigned)(2 * layer + 2), (PG8_LAS float*)(F.lds + RING_BYTES), F.wid0, fin ? 2 : ((layer & 1) ? 4 : 1)};
            pg8::gemm_phase<pg8::EpiResidualNorm, pg8::PanelOrder, true, true>(F.lds, g, S, E, F.wid0); }
        if (layer < DEPTH - 1) SEAM(pb + 8);
    }
#undef IN
#undef SEAM
#undef GRID_BAR
}

extern "C" void kernel_launch(void* const* d_in, const int* in_sizes, int n_in, void* d_out, int out_size, void* d_ws, size_t ws_size, hipStream_t stream) {
    static int grid = 0;
    if (grid == 0) {
        if (n_in != 20 || in_sizes[0] != NBATCH * SEQ * DM || out_size != NBATCH * SEQ * DM || ws_size < WS_END) {
            fprintf(stderr, "kernel_launch: unexpected shapes: n_in %d in0 %d out %d ws %zu (need %zu)\n", n_in, n_in > 0 ? in_sizes[0] : -1, out_size, ws_size, (size_t)WS_END); grid = -1; return; }
        int dev = 0, cus = 0, per_cu = 0;
        if (hipGetDevice(&dev) != hipSuccess || hipDeviceGetAttribute(&cus, hipDeviceAttributeMultiprocessorCount, dev) != hipSuccess) { grid = -1; return; }
        if (hipFuncSetAttribute((const void*)trunk_fwd, hipFuncAttributeMaxDynamicSharedMemorySize, LDS_BYTES) != hipSuccess) { fprintf(stderr, "kernel_launch: hipFuncSetAttribute failed\n"); grid = -1; return; }
        if (hipOccupancyMaxActiveBlocksPerMultiprocessor(&per_cu, (const void*)trunk_fwd, NWAVES * 64, LDS_BYTES) != hipSuccess || per_cu < 1)
            fprintf(stderr, "kernel_launch: note: occupancy query reports %d workgroups per CU\n", per_cu);
        (void)hipGetLastError();
        grid = cus;
    }
    if (grid < 0) return;
    (void)hipMemsetAsync((char*)d_ws + WS_CTL, 0, CTL_ZERO_BYTES, stream);
    Args a{};
    for (int i = 0; i < 20; ++i) a.in[i] = (const float*)d_in[i];
    a.out = (float*)d_out; a.ws = (unsigned char*)d_ws;
#if MK_PER_PHASE
    for (int p = 0; p < NPHASES; ++p) {
        const int k = (p - 1) % PH_PER_LAYER, layer = (p - 1) / PH_PER_LAYER;
        if (p >= 1 && p < NPHASES - 1 && (layer & 1) == 1 && k == 3) continue;
        a.ph_lo = p; a.ph_hi = p + 1;
        hipLaunchKernelGGL(trunk_fwd, dim3(grid), dim3(NWAVES * 64), LDS_BYTES, stream, a);
    }
#else
    a.ph_lo = 0; a.ph_hi = NPHASES;
    hipLaunchKernelGGL(trunk_fwd, dim3(grid), dim3(NWAVES * 64), LDS_BYTES, stream, a);
#endif
    const hipError_t le = hipPeekAtLastError();
    if (le != hipSuccess) fprintf(stderr, "kernel_launch: launch failed: %s\n", hipGetErrorName(le));
}
```

```cpp
#include <hip/hip_runtime.h>
#include <hip/hip_bf16.h>
#include <cstdio>
#include <cstdint>

#ifndef MK_PER_PHASE
#define MK_PER_PHASE 0
#endif

constexpr int DM = 2048, NBATCH = 2, SEQ = 8192, CTXL = 256, DEPTH = 4;
constexpr int ROWS_B = SEQ + CTXL;
constexpr int R = NBATCH * ROWS_B;
constexpr int PAN_B = ROWS_B / 256;
constexpr int NPAN = R / 256;
constexpr int QKVW = 6144, DFF = 5632, UPW = 2 * DFF, NMODW = 6 * DM;
constexpr float EPS = 1e-6f;
constexpr int NWAVES = 8;

__constant__ float INV_FREQ[32] = {1.f, 0.749894202f, 0.562341332f, 0.421696514f, 0.316227764f, 0.237137392f, 0.177827939f, 0.133352146f, 0.100000001f, 0.0749894157f, 0.0562341288f,
    0.0421696492f, 0.0316227786f, 0.0237137359f, 0.0177827943f, 0.0133352149f, 0.00999999978f, 0.00749894232f, 0.00562341325f, 0.00421696482f, 0.00316227786f, 0.00237137382f, 0.00177827943f,
    0.00133352145f, 0.00100000005f, 0.000749894185f, 0.000562341302f, 0.000421696546f, 0.000316227786f, 0.000237137385f, 0.00017782794f, 0.00013335215f};

__device__ __forceinline__ int opaque_tid(int wid_s) { int t; asm volatile("v_mbcnt_lo_u32_b32 %0, -1, 0\n\tv_mbcnt_hi_u32_b32 %0, -1, %0" : "=v"(t)); return wid_s * 64 + t; }

template <int X> __device__ __forceinline__ float swz_xor(float v) { return __builtin_bit_cast(float, __builtin_amdgcn_ds_swizzle(__builtin_bit_cast(int, v), (X << 10) | 0x1f)); }
__device__ __forceinline__ float half_sum32(float v) { v += swz_xor<1>(v); v += swz_xor<2>(v); v += swz_xor<4>(v); v += swz_xor<8>(v); v += swz_xor<16>(v); return v; }

namespace pg8 {
#define PG8_LAS __attribute__((address_space(3)))
typedef unsigned short bf16_t;
typedef short bf16x8 __attribute__((ext_vector_type(8)));
typedef float f32x4 __attribute__((ext_vector_type(4)));
typedef float f32x2 __attribute__((ext_vector_type(2)));
typedef unsigned u32x4 __attribute__((ext_vector_type(4)));
constexpr int BM = 256, BK = 64, HALF = 128, HTB = HALF * BK * 2  , STAGE_BYTES = 8 * HTB, NXCD = 8;

__host__ __device__ __forceinline__ int lds_byte(int r, int c) { const int st = (r >> 4) * 2 + (c >> 5), rr = r & 15, cc = c & 31, ob = rr * 64 + cc * 2; return st * 1024 + (ob ^ (((ob >> 9) & 1) << 5)); }
__host__ __device__ __forceinline__ void stage_rc(int b, int& R_, int& C_) { const int st = b / 1024, sb = b % 1024, swz = sb ^ (((sb >> 9) & 1) << 5); R_ = (st >> 1) * 16 + swz / 64; C_ = (st & 1) * 32 + (swz % 64) / 2; }
__host__ __device__ __forceinline__ int perm32(int rho) { const int n = rho >> 4, i = rho & 15; return 8 * (i >> 2) + 4 * n + (i & 3); }

struct Unit { int pm, pn, k0, nt, kpart, swap, part, pnb; };
struct Gemm { const bf16_t* A; const bf16_t* Bt; int K; };

struct PanelOrder {
    int nM, nN, nwg, G, c, ktiles, cfg;
    __device__ __forceinline__ void init(int nM_, int nN_, int G_, int c_, int skip_, int ktiles_, int ksplit_ = 0, int wgm_ = 4, int vswap_ = 0) { nM = nM_; nN = nN_; nwg = nM * nN; G = G_; c = c_; ktiles = ktiles_; cfg = skip_ | (ksplit_ << 4) | (wgm_ << 8) | (vswap_ << 16); }
    __device__ __forceinline__ bool next(int i, Unit& u) const {
        const int skip = cfg & 15, ksplit = (cfg >> 4) & 15, WGM = (cfg >> 8) & 255, vswap = cfg >> 16;
        const long L = (long)i * G + c;
        if (L >= nwg) { const int sidx = (int)(L - nwg); if (sidx >= 2 * nN * ksplit) return false;
            int ts, kp, per;
            if (ksplit == 11) { ts = sidx / 11; kp = sidx % 11; per = ktiles / 11; } else if (ksplit == 4) { ts = sidx >> 2; kp = sidx & 3; per = ktiles >> 2; } else if (ksplit == 2) { ts = sidx >> 1; kp = sidx & 1; per = ktiles >> 1; } else { ts = sidx; kp = 0; per = ktiles; }
            u.pm = (ts < nN) ? 32 : 65; u.pn = (ts < nN) ? ts : ts - nN; u.k0 = kp * per; u.nt = per; u.kpart = kp; u.swap = (vswap && u.pn >= vswap) ? 1 : 0; u.part = 0; u.pnb = u.pn; return true; }
        int wgid = (int)L; { const int q = nwg / NXCD, r = nwg % NXCD, xcd = wgid % NXCD, off = wgid / NXCD; wgid = (xcd < r ? xcd * (q + 1) : r * (q + 1) + (xcd - r) * q) + off; }
        const int nig = WGM * nN, gid = wgid / nig, fm = gid * WGM, gsz = (nM - fm) < WGM ? (nM - fm) : WGM;
        int pm = fm + ((wgid % nig) % gsz); u.pn = (wgid % nig) / gsz;
        if (skip) pm += (pm >= 32) ? 1 : 0;
        u.pm = pm; u.k0 = 0; u.nt = ktiles; u.kpart = -1; u.swap = (vswap && u.pn >= vswap) ? 1 : 0; u.part = 0; u.pnb = u.pn; return true;
    }
    __device__ __forceinline__ void a_ready(const Unit&) const {}
    __device__ __forceinline__ void done(const Unit&) const {}
};

struct QkvOrder {
    int G, c;
    __device__ __forceinline__ static void map(int nN, int L, int& pm, int& pn) {
        const int nwg = 64 * nN; int wgid = L; { const int q = nwg / NXCD, xcd = wgid % NXCD, off = wgid / NXCD; wgid = xcd * q + off; }
        const int nig = 4 * nN; pm = (wgid / nig) * 4 + ((wgid % nig) & 3); pn = (wgid % nig) >> 2; pm += (pm >= 32) ? 1 : 0;
    }
    __device__ __forceinline__ bool next(int i, Unit& u) const {
        u.k0 = 0; u.nt = DM / 128; u.kpart = -1;
        const int nq = (1024 - c + G - 1) / G, nv = (512 - c + G - 1) / G;
        if (i < nq) { map(16, i * G + c, u.pm, u.pn); u.swap = 0; u.part = 0; u.pnb = u.pn; return true; }
        i -= nq;
        if (i < 2 * nv) { int pn; map(8, (i >> 1) * G + c, u.pm, pn); u.pn = 16 + pn; u.swap = 1; u.part = 1 + (i & 1); u.pnb = u.pn + ((i & 1) ? 8 : 0); return true; }
        i -= 2 * nv;
        for (int x = c; x < 48; x += G) {
            if (i < 1) { if (x < 32) { u.pm = (x < 16) ? 32 : 65; u.pn = x & 15; u.swap = 0; u.part = 0; u.pnb = u.pn; }
                         else { const int y = x - 32; u.pm = (y < 8) ? 32 : 65; u.pn = 16 + (y & 7); u.swap = 1; u.part = 0; u.pnb = u.pn; }
                         return true; }
            i -= 1; }
        return false;
    }
    __device__ __forceinline__ void a_ready(const Unit&) const {}
    __device__ __forceinline__ void done(const Unit&) const {}
};

__device__ __forceinline__ unsigned cvt_pk_bf16(float lo, float hi) { unsigned r; asm volatile("v_cvt_pk_bf16_f32 %0, %1, %2" : "=v"(r) : "v"(lo), "v"(hi)); return r; }

struct EpiStoreBf16 {
    static constexpr bool PERM = true, AFTER_DRAIN = false, SIMPLE_STORE = true;
    bf16_t* O; int ldc;
    __device__ __forceinline__ void operator()(const f32x4 (&acc)[2][2][4][2], const Unit& u, int wr, int wc, int fr, int fq) const {
        const int row0 = u.pm * BM + wr * 64 + fr; const int col0 = u.pn * BM + wc * 32 + 8 * fq;
#pragma unroll
        for (int ai = 0; ai < 2; ++ai)
#pragma unroll
            for (int m = 0; m < 4; ++m) { bf16_t* rowp = O + (size_t)(row0 + ai * HALF + m * 16) * ldc + col0;
#pragma unroll
                for (int bj = 0; bj < 2; ++bj) { const f32x4 v0 = acc[ai][bj][m][0], v1 = acc[ai][bj][m][1];
                    u32x4 w; w.x = cvt_pk_bf16(v0[0], v0[1]); w.y = cvt_pk_bf16(v0[2], v0[3]); w.z = cvt_pk_bf16(v1[0], v1[1]); w.w = cvt_pk_bf16(v1[2], v1[3]);
                    *(u32x4*)(rowp + bj * HALF) = w; } }
    }
};
__device__ __forceinline__ long lane_off(int o) { asm volatile("" : "+v"(o)); return (long)o; }
__device__ __forceinline__ unsigned pk4_fp8(float a, float b, float c, float d) {
    int w = __builtin_amdgcn_cvt_pk_fp8_f32(a, b, 0, false); w = __builtin_amdgcn_cvt_pk_fp8_f32(c, d, w, true); return (unsigned)w; }
typedef unsigned u32x2 __attribute__((ext_vector_type(2)));
struct EpiQKV {
    static constexpr bool PERM = true, AFTER_DRAIN = false, SIMPLE_STORE = true;
    unsigned char* Q8; const float* rope; unsigned char* KT; unsigned char* VT; int wid0;
    __device__ __forceinline__ void operator()(const f32x4 (&acc)[2][2][4][2], const Unit& u, int wr_, int wc_, int fr_, int fq_) const {
        const int tid_ = opaque_tid(wid0), wid_ = __builtin_amdgcn_readfirstlane(tid_ >> 6), lane_ = tid_ & 63, wr = wid_ >> 2, wc = wid_ & 3, fr = lane_ & 15, fq = lane_ >> 4;
        (void)wr_; (void)wc_; (void)fr_; (void)fq_;
        const int pp = u.pm % PAN_B, bb = u.pm / PAN_B;
        if (u.swap) {
            const int hh_ = u.pn - 16;
#pragma unroll
            for (int ai = 0; ai < 2; ++ai)
#pragma unroll
                for (int m = 0; m < 4; ++m) { const int vc = ai * HALF + wr * 64 + m * 16 + fr, cb = vc >> 5, nn = vc & 31;
#pragma unroll
                    for (int bj = 0; bj < 2; ++bj) { const int jt = pp * 4 + 2 * bj + (wc >> 1), f = wc & 1;
                        unsigned char* img = VT + (size_t)((bb * 8 + hh_) * 132 + jt) * 16384 + lane_off(cb * 2048 + f * 1024 + 4 * fq + nn * 16);
                        const f32x4 v0 = acc[ai][bj][m][0], v1 = acc[ai][bj][m][1];
                        constexpr float IW = 1.f / 64.f;
                        *(unsigned*)(img) = pk4_fp8(v0[0] * IW, v0[1] * IW, v0[2] * IW, v0[3] * IW);
                        *(unsigned*)(img + 512) = pk4_fp8(v1[0] * IW, v1[1] * IW, v1[2] * IW, v1[3] * IW); } }
            return; }
        const bool do_rope = (pp != 32);
        const int t0 = pp * 256 + wr * 64 + fr; const int f0 = 16 * (wc & 1) + 4 * fq;
        const int cl = wc * 32 + 8 * fq;
#pragma unroll
        for (int ai = 0; ai < 2; ++ai)
#pragma unroll
            for (int m = 0; m < 4; ++m) { const int rowu = u.pm * BM + ai * HALF + wr * 64 + m * 16 + fr;
                const int jt = pp * 4 + 2 * ai + wr, kr = 16 * m + fr;
                f32x4 cs0 = (f32x4){1.f, 0.f, 1.f, 0.f}, cs1 = cs0;
                if (do_rope) { const int t = t0 + ai * HALF + m * 16; const int pos = (wc < 2) ? (t >> 6) : (t & 63);
                    const f32x4* cp = (const f32x4*)(rope + (size_t)(pos * 32 + f0) * 2); cs0 = cp[0]; cs1 = cp[1]; }
#pragma unroll
                for (int bj = 0; bj < 2; ++bj) { const f32x4 v0 = acc[ai][bj][m][0], v1 = acc[ai][bj][m][1];
                    const float a0 = v0[0] * cs0[0] - v0[1] * cs0[1], a1 = v0[1] * cs0[0] + v0[0] * cs0[1];
                    const float a2 = v0[2] * cs0[2] - v0[3] * cs0[3], a3 = v0[3] * cs0[2] + v0[2] * cs0[3];
                    const float b0 = v1[0] * cs1[0] - v1[1] * cs1[1], b1 = v1[1] * cs1[0] + v1[0] * cs1[1];
                    const float b2 = v1[2] * cs1[2] - v1[3] * cs1[3], b3 = v1[3] * cs1[2] + v1[2] * cs1[3];
                    constexpr float SQC = 0.3570958286295132f / 64.f;
                    u32x2 w; w.x = pk4_fp8(a0 * SQC, a1 * SQC, a2 * SQC, a3 * SQC); w.y = pk4_fp8(b0 * SQC, b1 * SQC, b2 * SQC, b3 * SQC);
                    unsigned char* dst;
                    if (u.pn < 8) dst = Q8 + lane_off(rowu * DM + u.pn * BM + bj * HALF + cl);
                    else { const int hs = (u.pn - 8) * 2 + bj;
                        dst = KT + (size_t)((bb * 16 + hs) * 132 + jt) * 8192 + lane_off((((kr >> 5) * 2 + (cl >> 6)) * 2 + ((cl >> 4) & 1)) * 1024 + ((kr & 31) + 32 * ((cl >> 5) & 1)) * 16 + (cl & 15)); }
                    *(u32x2*)dst = w; } }
    }
};
struct EpiResidual {
    static constexpr bool PERM = false, AFTER_DRAIN = false, SIMPLE_STORE = false;
    float* X; const float* gate3; int gstride; const float* xin; const float* cin; float* slab; const float* zeros;
    __device__ __forceinline__ void operator()(const f32x4 (&acc)[2][2][4][2], const Unit& u, int wr, int wc, int fr, int fq) const {
        const int pp = u.pm % PAN_B, bb = u.pm / PAN_B; const int set = (pp == 32) ? 2 : bb;
        const float* g = gate3 + (size_t)set * gstride;
        const int col0 = u.pn * BM + wc * 32 + 4 * fq;
        f32x4 gv[2][2];
#pragma unroll
        for (int bj = 0; bj < 2; ++bj)
#pragma unroll
            for (int n = 0; n < 2; ++n) gv[bj][n] = *(const f32x4*)(g + col0 + bj * HALF + n * 16);
        const bool part = u.kpart >= 0;
        float* dstb = part ? slab + ((size_t)u.kpart * 512 + (size_t)bb * 256) * DM : X + (size_t)u.pm * BM * DM;
        const float* srcb = part ? zeros : (xin ? ((pp == 32) ? cin + (size_t)bb * CTXL * DM : xin + (size_t)(bb * SEQ + pp * 256) * DM) : X + (size_t)u.pm * BM * DM);
        const size_t sstr = part ? 0 : DM;
#pragma unroll
        for (int ai = 0; ai < 2; ++ai)
#pragma unroll
            for (int m = 0; m < 4; ++m) { const int rr = ai * HALF + wr * 64 + m * 16 + fr; float* rowp = dstb + (size_t)rr * DM + col0; const float* rowb = srcb + (size_t)rr * sstr + col0;
#pragma unroll
                for (int bj = 0; bj < 2; ++bj)
#pragma unroll
                    for (int n = 0; n < 2; ++n) { const f32x4 x = *(const f32x4*)(rowb + bj * HALF + n * 16); *(f32x4*)(rowp + bj * HALF + n * 16) = x + gv[bj][n] * acc[ai][bj][m][n]; }
                if (m & 1) asm volatile("" ::: "memory"); }
    }
};
struct EpiResidualNorm {
    static constexpr bool PERM = true, AFTER_DRAIN = false, SIMPLE_STORE = false;
    float* X; const float* gate3; const float* xin; float* slab; const float* zeros; const float* va; void* dst; float* xbuf; unsigned* cnt; unsigned want; PG8_LAS float* T; int wid0; int mode;
    __device__ __forceinline__ void operator()(f32x4 (&acc)[2][2][4][2], const Unit& u, int wr, int wc, int fr, int fq) const {
        const int pp = u.pm % PAN_B, bb = u.pm / PAN_B; const int set = (pp == 32) ? 2 : bb;
        const float* g = gate3 + (size_t)set * NMODW;
        const int col0 = u.pn * BM + wc * 32 + 8 * fq;
        PG8_LAS float* P = T; PG8_LAS float* S = T + 1024;
        {   f32x4 gv[2][2];
#pragma unroll
            for (int bj = 0; bj < 2; ++bj)
#pragma unroll
                for (int n = 0; n < 2; ++n) gv[bj][n] = *(const f32x4*)(g + col0 + bj * HALF + 4 * n);
            const bool part = u.kpart >= 0;
            float* xb = (part ? slab + ((size_t)u.kpart * 512 + (size_t)bb * 256) * DM : X + (size_t)u.pm * BM * DM) + col0;
            const float* sb = (part ? zeros : (xin ? xin + (size_t)(bb * SEQ + pp * 256) * DM : X + (size_t)u.pm * BM * DM)) + col0;
            const size_t sstr = part ? 0 : DM;
#pragma unroll
            for (int ai = 0; ai < 2; ++ai)
#pragma unroll
                for (int mb = 0; mb < 4; mb += 2) { f32x4 t[2][2][2];
#pragma unroll
                    for (int mm = 0; mm < 2; ++mm) { const float* rowb = sb + (size_t)(ai * HALF + wr * 64 + (mb + mm) * 16 + fr) * sstr;
#pragma unroll
                        for (int bj = 0; bj < 2; ++bj)
#pragma unroll
                            for (int n = 0; n < 2; ++n) t[mm][bj][n] = *(const f32x4*)(rowb + bj * HALF + 4 * n); }
#pragma unroll
                    for (int mm = 0; mm < 2; ++mm) { const int m = mb + mm, rr = ai * HALF + wr * 64 + m * 16 + fr; float* rowx = xb + (size_t)rr * DM; float q = 0.f;
#pragma unroll
                        for (int bj = 0; bj < 2; ++bj)
#pragma unroll
                            for (int n = 0; n < 2; ++n) { const f32x4 x = t[mm][bj][n] + gv[bj][n] * acc[ai][bj][m][n]; acc[ai][bj][m][n] = x;
                                if (mode != 2) *(f32x4*)(rowx + bj * HALF + 4 * n) = x;
                                q += (x[0] * x[0] + x[1] * x[1]) + (x[2] * x[2] + x[3] * x[3]); }
                        q += swz_xor<16>(q);
                        { auto r2 = __builtin_amdgcn_permlane32_swap(__float_as_uint(q), __float_as_uint(q), false, false); q = __uint_as_float(r2[0]) + __uint_as_float(r2[1]); }
                        if (fq == 0) P[rr * 4 + wc] = q; }
                    asm volatile("" ::: "memory"); } }
        const bool whole = u.kpart < 0;
        asm volatile("s_waitcnt lgkmcnt(0)\n\ts_barrier" ::: "memory");
        const int tid = opaque_tid(wid0), wid = __builtin_amdgcn_readfirstlane(tid >> 6), lane = tid & 63;
        const int row = wid * 32 + (lane & 31);
        float* slot = xbuf + ((size_t)u.pm * BM + row) * 8;
        if (whole && lane < 32) { const float t = (P[row * 4 + 0] + P[row * 4 + 1]) + (P[row * 4 + 2] + P[row * 4 + 3]);
            __hip_atomic_store(slot + u.pn, t, __ATOMIC_RELAXED, __HIP_MEMORY_SCOPE_AGENT); }
        asm volatile("s_waitcnt vmcnt(0)" ::: "memory");
        if (whole && lane == 0) __hip_atomic_fetch_add(cnt + 64 * u.pm, 1u, __ATOMIC_RELAXED, __HIP_MEMORY_SCOPE_AGENT);
        if (whole && wid == 0) {
            for (int it = 0; it < (1 << 22); ++it) {
                if ((unsigned)__builtin_amdgcn_readfirstlane(__hip_atomic_load(cnt + 64 * u.pm, __ATOMIC_RELAXED, __HIP_MEMORY_SCOPE_AGENT)) >= want) break;
                __builtin_amdgcn_s_sleep(2); }
            __builtin_amdgcn_fence(__ATOMIC_ACQUIRE, "agent"); }
        asm volatile("s_waitcnt vmcnt(0) lgkmcnt(0)\n\ts_barrier" ::: "memory");
        if (whole && lane < 32) { float t[8];
#pragma unroll
            for (int k = 0; k < 8; ++k) t[k] = __hip_atomic_load(slot + k, __ATOMIC_RELAXED, __HIP_MEMORY_SCOPE_AGENT);
            const float ss = ((t[0] + t[1]) + (t[2] + t[3])) + ((t[4] + t[5]) + (t[6] + t[7]));
            S[row] = 1.0f / sqrtf(ss * (1.f / DM) + 1e-6f); }
        asm volatile("s_waitcnt vmcnt(0) lgkmcnt(0)\n\ts_barrier" ::: "memory");
        const float* pa = va + ((mode == 2) ? (size_t)0 : (size_t)bb * NMODW) + col0;
        if (whole)
#pragma unroll
        for (int bj = 0; bj < 2; ++bj) {
            const f32x4 a0 = *(const f32x4*)(pa + bj * HALF), a1 = *(const f32x4*)(pa + bj * HALF + 4);
            if (mode == 2) {
                float* dstb = (float*)dst + ((size_t)bb * SEQ + (size_t)pp * BM) * DM + col0 + bj * HALF;
#pragma unroll
                for (int ai = 0; ai < 2; ++ai)
#pragma unroll
                    for (int m = 0; m < 4; ++m) { const int rr = ai * HALF + wr * 64 + m * 16 + fr; const float rs = S[rr]; float* rowp = dstb + (size_t)rr * DM;
                        *(f32x4*)(rowp) = (acc[ai][bj][m][0] * rs) * a0; *(f32x4*)(rowp + 4) = (acc[ai][bj][m][1] * rs) * a1; }
            } else {
                const f32x4 s0 = *(const f32x4*)(pa + DM + bj * HALF) + 1.0f, s1 = *(const f32x4*)(pa + DM + bj * HALF + 4) + 1.0f;
#pragma unroll
                for (int ai = 0; ai < 2; ++ai)
#pragma unroll
                    for (int m = 0; m < 4; ++m) { const int rr = ai * HALF + wr * 64 + m * 16 + fr; const float rs = S[rr];
                        const f32x4 y0 = (acc[ai][bj][m][0] * rs) * s0 + a0, y1 = (acc[ai][bj][m][1] * rs) * s1 + a1;
                        if (mode == 1) { u32x4 w; w.x = cvt_pk_bf16(y0[0], y0[1]); w.y = cvt_pk_bf16(y0[2], y0[3]); w.z = cvt_pk_bf16(y1[0], y1[1]); w.w = cvt_pk_bf16(y1[2], y1[3]);
                            *(u32x4*)((bf16_t*)dst + (size_t)(u.pm * BM + rr) * DM + col0 + bj * HALF) = w; }
                        else { u32x2 w; w.x = pk4_fp8(y0[0], y0[1], y0[2], y0[3]); w.y = pk4_fp8(y1[0], y1[1], y1[2], y1[3]);
                            *(u32x2*)((unsigned char*)dst + (size_t)(u.pm * BM + rr) * DM + col0 + bj * HALF) = w; } }
            }
        }
    }
};
__device__ __forceinline__ float dpp_ror1(float v) { return __builtin_bit_cast(float, __builtin_amdgcn_update_dpp(__builtin_bit_cast(int, v), __builtin_bit_cast(int, v), 0x121, 0xf, 0xf, true)); }
__device__ __forceinline__ float dpp_rol1(float v) { return __builtin_bit_cast(float, __builtin_amdgcn_update_dpp(__builtin_bit_cast(int, v), __builtin_bit_cast(int, v), 0x12F, 0xf, 0xf, true)); }
__device__ __forceinline__ float shr1_or(float v, float o) { return __builtin_bit_cast(float, __builtin_amdgcn_update_dpp(__builtin_bit_cast(int, o), __builtin_bit_cast(int, v), 0x111, 0xf, 0xf, false)); }
__device__ __forceinline__ float shl1_or(float v, float o) { return __builtin_bit_cast(float, __builtin_amdgcn_update_dpp(__builtin_bit_cast(int, o), __builtin_bit_cast(int, v), 0x101, 0xf, 0xf, false)); }
#define PG8_FMAC_DPP(c_, src_, w_, CTRL) asm("v_fmac_f32_dpp %0, %1, %2 " CTRL " row_mask:0xf bank_mask:0xf" : "+v"(c_) : "v"(src_), "v"(w_))
struct EpiConvGate {
    static constexpr bool PERM = true, AFTER_DRAIN = false, SIMPLE_STORE = false;
    bf16_t* ACT; float* YE; const float* cw; PG8_LAS float* E; float* YS;
    __device__ __forceinline__ void operator()(const f32x4 (&acc)[2][2][4][2], const Unit& u, int wr, int wc, int fr, int fq) const {
        const int cb = wc * 32 + 8 * fq;
        const bool is0 = (fr == 0), is15 = (fr == 15);
        const bool part = (YS != nullptr) && (u.pm % PAN_B) == 32;
        if (part) { float* yb = YS + ((size_t)u.kpart * 512 + (size_t)(u.pm / PAN_B) * 256 + wr * 64 + fr) * UPW + u.pn * 256 + cb;
#pragma unroll
            for (int ai = 0; ai < 2; ++ai)
#pragma unroll
                for (int m = 0; m < 4; ++m)
#pragma unroll
                    for (int bj = 0; bj < 2; ++bj)
#pragma unroll
                        for (int n = 0; n < 2; ++n) *(f32x4*)(yb + (size_t)(ai * HALF + m * 16) * UPW + bj * 128 + 4 * n) = acc[ai][bj][m][n]; }
        if (!part)
#pragma unroll
        for (int ai = 0; ai < 2; ++ai) { const int q = 2 * ai + wr;
#pragma unroll
            for (int bj = 0; bj < 2; ++bj)
#pragma unroll
                for (int n = 0; n < 2; ++n) {
                    if (is0) *(PG8_LAS f32x4*)(E + (q * 2 + 0) * 256 + bj * 128 + cb + 4 * n) = acc[ai][bj][0][n];
                    if (is15) *(PG8_LAS f32x4*)(E + (q * 2 + 1) * 256 + bj * 128 + cb + 4 * n) = acc[ai][bj][3][n]; } }
        f32x4 w[3][2][2];
#pragma unroll
        for (int j = 0; j < 3; ++j)
#pragma unroll
            for (int bj = 0; bj < 2; ++bj)
#pragma unroll
                for (int n = 0; n < 2; ++n) w[j][bj][n] = *(const f32x4*)(cw + (size_t)j * UPW + bj * DFF + u.pn * 128 + cb + 4 * n);
        if (!part) {   float* ye = YE + (size_t)u.pm * 4 * UPW + u.pn * 256 + cb;
            if (wr == 0 && fr < 2) {
#pragma unroll
                for (int bj = 0; bj < 2; ++bj)
#pragma unroll
                    for (int n = 0; n < 2; ++n) *(f32x4*)(ye + (size_t)fr * UPW + bj * 128 + 4 * n) = acc[0][bj][0][n]; }
            if (wr == 1 && fr >= 14) {
#pragma unroll
                for (int bj = 0; bj < 2; ++bj)
#pragma unroll
                    for (int n = 0; n < 2; ++n) *(f32x4*)(ye + (size_t)(fr - 12) * UPW + bj * 128 + 4 * n) = acc[1][bj][3][n]; } }
        asm volatile("s_waitcnt lgkmcnt(0)\n\ts_barrier" ::: "memory");
        if (!part)
#pragma unroll
        for (int ai = 0; ai < 2; ++ai) { const int q = 2 * ai + wr;
            f32x4 ep[2][2], en[2][2];
#pragma unroll
            for (int bj = 0; bj < 2; ++bj)
#pragma unroll
                for (int n = 0; n < 2; ++n) { ep[bj][n] = (f32x4){0.f, 0.f, 0.f, 0.f}; en[bj][n] = ep[bj][n];
                    if (is0 && q > 0) ep[bj][n] = *(const PG8_LAS f32x4*)(E + ((q - 1) * 2 + 1) * 256 + bj * 128 + cb + 4 * n);
                    if (is15 && q < 3) en[bj][n] = *(const PG8_LAS f32x4*)(E + ((q + 1) * 2 + 0) * 256 + bj * 128 + cb + 4 * n); }
#pragma unroll
            for (int m = 0; m < 4; ++m) { u32x4 ow;
#pragma unroll
                for (int n = 0; n < 2; ++n) { f32x4 cv[2];
#pragma unroll
                    for (int bj = 0; bj < 2; ++bj) { const f32x4 cur = acc[ai][bj][m][n];
#pragma unroll
                        for (int e = 0; e < 4; ++e) { const float w0 = w[0][bj][n][e], w2 = w[2][bj][n][e]; float c = w[1][bj][n][e] * cur[e];
                            PG8_FMAC_DPP(c, cur[e], w0, "row_shr:1");
                            if (m == 0) c = __builtin_fmaf(w0, ep[bj][n][e], c); else PG8_FMAC_DPP(c, acc[ai][bj][m > 0 ? m - 1 : 0][n][e], w0, "row_shl:15");
                            PG8_FMAC_DPP(c, cur[e], w2, "row_shl:1");
                            if (m == 3) c = __builtin_fmaf(w2, en[bj][n][e], c); else PG8_FMAC_DPP(c, acc[ai][bj][m < 3 ? m + 1 : 3][n][e], w2, "row_shr:15");
                            cv[bj][e] = c; } }
                    float a[4];
#pragma unroll
                    for (int e = 0; e < 4; ++e) { const float g = cv[0][e]; a[e] = g * __builtin_amdgcn_rcpf(1.f + __builtin_amdgcn_exp2f(-1.4426950408889634f * g)) * cv[1][e]; }
                    ow[2 * n] = cvt_pk_bf16(a[0], a[1]); ow[2 * n + 1] = cvt_pk_bf16(a[2], a[3]); }
                const bool skip = (q == 0 && m == 0 && is0) || (q == 3 && m == 3 && is15);
                if (!skip) *(u32x4*)(ACT + (size_t)(u.pm * BM + ai * HALF + wr * 64 + m * 16 + fr) * DFF + u.pn * 128 + cb) = ow; } }
    }
};

struct EpiSconv {
    static constexpr bool PERM = true, AFTER_DRAIN = false, SIMPLE_STORE = false;
    bf16_t* GB; bf16_t* CZ; float* PE; const float* cw; PG8_LAS float* E;
    __device__ __forceinline__ void operator()(const f32x4 (&acc)[2][2][4][2], const Unit& u, int wr, int wc, int fr, int fq) const {
        const int cb = wc * 32 + 8 * fq;
        if (u.pn >= 16) {
            const int row0 = u.pm * BM + wr * 64 + fr; const int col0 = (u.pn - 16) * BM + cb;
#pragma unroll
            for (int ai = 0; ai < 2; ++ai)
#pragma unroll
                for (int m = 0; m < 4; ++m) { bf16_t* rowp = GB + (size_t)(row0 + ai * HALF + m * 16) * DM + col0;
#pragma unroll
                    for (int bj = 0; bj < 2; ++bj) { const f32x4 v0 = acc[ai][bj][m][0], v1 = acc[ai][bj][m][1];
                        u32x4 w; w.x = cvt_pk_bf16(v0[0], v0[1]); w.y = cvt_pk_bf16(v0[2], v0[3]); w.z = cvt_pk_bf16(v1[0], v1[1]); w.w = cvt_pk_bf16(v1[2], v1[3]);
                        *(u32x4*)(rowp + bj * HALF) = w; } }
            return; }
        const bool is0 = (fr == 0), is15 = (fr == 15);
        f32x4 p[2][4][2];
#pragma unroll
        for (int ai = 0; ai < 2; ++ai)
#pragma unroll
            for (int m = 0; m < 4; ++m)
#pragma unroll
                for (int n = 0; n < 2; ++n) p[ai][m][n] = acc[ai][0][m][n] * acc[ai][1][m][n];
#pragma unroll
        for (int ai = 0; ai < 2; ++ai) { const int q = 2 * ai + wr;
#pragma unroll
            for (int n = 0; n < 2; ++n) {
                if (is0) *(PG8_LAS f32x4*)(E + (q * 2 + 0) * 128 + cb + 4 * n) = p[ai][0][n];
                if (is15) *(PG8_LAS f32x4*)(E + (q * 2 + 1) * 128 + cb + 4 * n) = p[ai][3][n]; } }
        f32x4 w[3][2];
#pragma unroll
        for (int j = 0; j < 3; ++j)
#pragma unroll
            for (int n = 0; n < 2; ++n) w[j][n] = *(const f32x4*)(cw + (size_t)j * DM + u.pn * 128 + cb + 4 * n);
        {   float* pe = PE + (size_t)u.pm * 4 * DM + u.pn * 128 + cb;
            if (wr == 0 && fr < 2) {
#pragma unroll
                for (int n = 0; n < 2; ++n) *(f32x4*)(pe + (size_t)fr * DM + 4 * n) = p[0][0][n]; }
            if (wr == 1 && fr >= 14) {
#pragma unroll
                for (int n = 0; n < 2; ++n) *(f32x4*)(pe + (size_t)(fr - 12) * DM + 4 * n) = p[1][3][n]; } }
        asm volatile("s_waitcnt lgkmcnt(0)\n\ts_barrier" ::: "memory");
#pragma unroll
        for (int ai = 0; ai < 2; ++ai) { const int q = 2 * ai + wr;
            f32x4 ep[2], en[2];
#pragma unroll
            for (int n = 0; n < 2; ++n) { ep[n] = (f32x4){0.f, 0.f, 0.f, 0.f}; en[n] = ep[n];
                if (is0 && q > 0) ep[n] = *(const PG8_LAS f32x4*)(E + ((q - 1) * 2 + 1) * 128 + cb + 4 * n);
                if (is15 && q < 3) en[n] = *(const PG8_LAS f32x4*)(E + ((q + 1) * 2 + 0) * 128 + cb + 4 * n); }
#pragma unroll
            for (int m = 0; m < 4; ++m) { u32x4 ow;
#pragma unroll
                for (int n = 0; n < 2; ++n) { const f32x4 cur = p[ai][m][n];
                    f32x4 pv, nx;
#pragma unroll
                    for (int e = 0; e < 4; ++e) {
                        pv[e] = shr1_or(cur[e], (m == 0) ? ep[n][e] : dpp_ror1(p[ai][m > 0 ? m - 1 : 0][n][e]));
                        nx[e] = shl1_or(cur[e], (m == 3) ? en[n][e] : dpp_rol1(p[ai][m < 3 ? m + 1 : 3][n][e])); }
                    const f32x4 c = w[0][n] * pv + w[1][n] * cur + w[2][n] * nx;
                    ow[2 * n] = cvt_pk_bf16(c[0], c[1]); ow[2 * n + 1] = cvt_pk_bf16(c[2], c[3]); }
                const bool skip = (q == 0 && m == 0 && is0) || (q == 3 && m == 3 && is15);
                if (!skip) *(u32x4*)(CZ + (size_t)(u.pm * BM + ai * HALF + wr * 64 + m * 16 + fr) * DM + u.pn * 128 + cb) = ow; } }
    }
};

template <class Epi, class Sched, bool ALIGN_EPI = false, bool SP2 = false, bool FP8 = false>
__device__ __forceinline__ void gemm_phase(PG8_LAS unsigned char* lds, const Gemm g, const Sched& S, const Epi& E, int wid0) {
#ifdef NO_GEMM
    return;
#endif
    const int tid = opaque_tid(wid0), wid = __builtin_amdgcn_readfirstlane(tid >> 6), lane = tid & 63, wr = wid >> 2, wc = wid & 3, fr = lane & 15, fq = lane >> 4;
    const int K = g.K; int nt; constexpr int ES = FP8 ? 1 : 2;
    unsigned voffA, voffB;
    { int R_, C_; stage_rc(tid * 16, R_, C_); const int Rb = Epi::PERM ? ((R_ & ~31) + perm32(R_ & 31)) : R_;
        voffA = (unsigned)(R_ * K * ES + C_ * 2); voffB = (unsigned)(Rb * K * ES + C_ * 2); }
    const size_t rstep64 = (size_t)64 * K * ES;
    const size_t kstep = (size_t)(BK * 2);
    const size_t hstep = (size_t)HALF * K * ES;
    const size_t tstep = 2 * hstep;
    const unsigned ldsw = (unsigned)wid * 1024u;
    const int aoff = lds_byte(wr * 64 + fr, fq * 8), boff = lds_byte(wc * 32 + fr, fq * 8);
#define PG8_SA(b, h) (((b) * 2 + (h)) * HTB)
#define PG8_SB(b, h) ((4 + (b) * 2 + (h)) * HTB)
#define PG8_STAGE(bufoff, gbase, voff) do { _Pragma("unroll") for (int _i = 0; _i < 2; ++_i) \
        __builtin_amdgcn_global_load_lds((const unsigned*)(((const char*)(gbase) + _i * rstep64) + (voff)), (PG8_LAS unsigned*)(lds + (bufoff) + ldsw + _i * 8192), 16, 0, 0); } while (0)
#define PG8_LDA(dst, b, h) do { if constexpr (FP8) { _Pragma("unroll") for (int m = 0; m < 4; ++m) { dst##8[m].lo = *(const PG8_LAS v4i_*)(lds + PG8_SA(b, h) + aoff + m * 2048); dst##8[m].hi = *(const PG8_LAS v4i_*)(lds + PG8_SA(b, h) + aoff + m * 2048 + 1024); } } \
        else { _Pragma("unroll") for (int m = 0; m < 4; ++m) _Pragma("unroll") for (int k = 0; k < 2; ++k) dst[m][k] = *(const PG8_LAS bf16x8*)(lds + PG8_SA(b, h) + aoff + m * 2048 + k * 1024); } } while (0)
#define PG8_LDB(dst, b, h) do { if constexpr (FP8) { _Pragma("unroll") for (int n = 0; n < 2; ++n) { dst##8[n].lo = *(const PG8_LAS v4i_*)(lds + PG8_SB(b, h) + boff + n * 2048); dst##8[n].hi = *(const PG8_LAS v4i_*)(lds + PG8_SB(b, h) + boff + n * 2048 + 1024); } } \
        else { _Pragma("unroll") for (int n = 0; n < 2; ++n) _Pragma("unroll") for (int k = 0; k < 2; ++k) dst[n][k] = *(const PG8_LAS bf16x8*)(lds + PG8_SB(b, h) + boff + n * 2048 + k * 1024); } } while (0)
#define PG8_MMA(ai, bj, At, Bt) do { __builtin_amdgcn_s_setprio(1); \
        if constexpr (FP8) { _Pragma("unroll") for (int m = 0; m < 4; ++m) _Pragma("unroll") for (int n = 0; n < 2; ++n) \
                acc[ai][bj][m][n] = __builtin_amdgcn_mfma_scale_f32_16x16x128_f8f6f4(Bt##8[n], At##8[m], acc[ai][bj][m][n], 0, 0, 0, 0, 0, 0); } \
        else { _Pragma("unroll") for (int m = 0; m < 4; ++m) _Pragma("unroll") for (int n = 0; n < 2; ++n) _Pragma("unroll") for (int k = 0; k < 2; ++k) \
            acc[ai][bj][m][n] = __builtin_amdgcn_mfma_f32_16x16x32_bf16(Bt[n][k], At[m][k], acc[ai][bj][m][n], 0, 0, 0); } \
        __builtin_amdgcn_s_setprio(0); } while (0)
#define PG8_WAIT_V(n) asm volatile("s_waitcnt vmcnt(" #n ")" ::: "memory")
#define PG8_WAIT_L(n) asm volatile("s_waitcnt lgkmcnt(" #n ")" ::: "memory")
#define PG8_BAR __builtin_amdgcn_s_barrier()
#define PG8_SCHED __builtin_amdgcn_sched_barrier(0)
    Unit cur, nxt; int ui = 0;
    if (!S.next(0, cur)) return;
    f32x4 acc[2][2][4][2];
#pragma unroll
    for (int a = 0; a < 2; ++a)
#pragma unroll
        for (int b = 0; b < 2; ++b)
#pragma unroll
            for (int m = 0; m < 4; ++m)
#pragma unroll
                for (int n = 0; n < 2; ++n) acc[a][b][m][n] = (f32x4){0.f, 0.f, 0.f, 0.f};
    bf16x8 At[4][2], B0[2][2], B1[2][2];
    typedef int v8i_ __attribute__((ext_vector_type(8))); typedef int v4i_ __attribute__((ext_vector_type(4)));
    v8i_ At8[4], B08[2], B18[2];
    const char* cA = (cur.swap ? (const char*)g.Bt + (size_t)cur.pnb * tstep : (const char*)g.A + (size_t)cur.pm * tstep) + (size_t)cur.k0 * kstep;
    const char* cB = (cur.swap ? (const char*)g.A + (size_t)cur.pm * tstep : (const char*)g.Bt + (size_t)cur.pnb * tstep) + (size_t)cur.k0 * kstep;
    nt = cur.nt;
    S.a_ready(cur);
    if constexpr (SP2) {
        PG8_STAGE(PG8_SB(0, 0), cB, voffB); PG8_STAGE(PG8_SB(0, 1), cB + hstep, voffB); PG8_STAGE(PG8_SA(0, 0), cA, voffA); PG8_STAGE(PG8_SA(0, 1), cA + hstep, voffA);
        if (wr == 1) PG8_BAR;
        PG8_WAIT_V(2); PG8_BAR;
        PG8_STAGE(PG8_SB(1, 0), cB + kstep, voffB); PG8_STAGE(PG8_SA(1, 0), cA + kstep, voffA); PG8_STAGE(PG8_SB(1, 1), cB + hstep + kstep, voffB);
        PG8_WAIT_V(6); PG8_BAR;
    } else {
        PG8_STAGE(PG8_SB(0, 0), cB, voffB); PG8_STAGE(PG8_SA(0, 0), cA, voffA); PG8_STAGE(PG8_SB(0, 1), cB + hstep, voffB); PG8_STAGE(PG8_SA(0, 1), cA + hstep, voffA);
        if (wr == 1) PG8_BAR;
        PG8_WAIT_V(4); PG8_BAR;
        PG8_STAGE(PG8_SB(1, 0), cB + kstep, voffB); PG8_STAGE(PG8_SA(1, 0), cA + kstep, voffA); PG8_STAGE(PG8_SB(1, 1), cB + hstep + kstep, voffB);
        PG8_WAIT_V(6); PG8_BAR;
    }
    for (;;) {
        const bool has_next = S.next(ui + 1, nxt);
        const char* nA = has_next ? (nxt.swap ? (const char*)g.Bt + (size_t)nxt.pnb * tstep : (const char*)g.A + (size_t)nxt.pm * tstep) + (size_t)nxt.k0 * kstep : cA;
        const char* nB = has_next ? (nxt.swap ? (const char*)g.A + (size_t)nxt.pm * tstep : (const char*)g.Bt + (size_t)nxt.pnb * tstep) + (size_t)nxt.k0 * kstep : cB;
        for (int t = 0; t < nt; t += 2) {
            const bool last = (t == nt - 2);
            const char* a1 = cA + (size_t)(t + 1) * kstep;
            const char* a2 = last ? nA : cA + (size_t)(t + 2) * kstep; const char* b2 = last ? nB : cB + (size_t)(t + 2) * kstep;
            const char* a3 = a2 + kstep; const char* b3 = b2 + kstep;
            if (last && has_next) S.a_ready(nxt);
            if constexpr (SP2) {
            PG8_LDB(B0, 0, 0); PG8_LDB(B1, 0, 1); PG8_SCHED; PG8_LDA(At, 0, 0); PG8_STAGE(PG8_SA(1, 1), a1 + hstep, voffA);
            PG8_WAIT_V(8); PG8_WAIT_L(0); PG8_BAR; PG8_MMA(0, 0, At, B0); PG8_MMA(0, 1, At, B1); PG8_BAR; PG8_SCHED;
            PG8_LDA(At, 0, 1); PG8_STAGE(PG8_SB(0, 0), b2, voffB); PG8_STAGE(PG8_SB(0, 1), b2 + hstep, voffB); PG8_STAGE(PG8_SA(0, 0), a2, voffA);
            PG8_WAIT_V(8); PG8_WAIT_L(0); PG8_BAR; PG8_MMA(1, 0, At, B0); PG8_MMA(1, 1, At, B1); PG8_BAR; PG8_SCHED;
            PG8_LDB(B0, 1, 0); PG8_LDB(B1, 1, 1); PG8_SCHED; PG8_LDA(At, 1, 0); PG8_STAGE(PG8_SA(0, 1), a2 + hstep, voffA);
            PG8_WAIT_V(8); PG8_WAIT_L(0); PG8_BAR; PG8_MMA(0, 0, At, B0); PG8_MMA(0, 1, At, B1); PG8_BAR; PG8_SCHED;
            PG8_LDA(At, 1, 1); PG8_STAGE(PG8_SB(1, 0), b3, voffB); PG8_STAGE(PG8_SB(1, 1), b3 + hstep, voffB); PG8_STAGE(PG8_SA(1, 0), a3, voffA);
            PG8_WAIT_V(8); PG8_WAIT_L(0); PG8_BAR; PG8_MMA(1, 0, At, B0); PG8_MMA(1, 1, At, B1); PG8_BAR; PG8_SCHED;
            } else {
            PG8_LDB(B0, 0, 0); PG8_SCHED; PG8_LDA(At, 0, 0); PG8_STAGE(PG8_SA(1, 1), a1 + hstep, voffA);
            PG8_WAIT_L(8); PG8_BAR; PG8_WAIT_L(0); PG8_MMA(0, 0, At, B0); PG8_BAR; PG8_SCHED;
            PG8_LDB(B1, 0, 1); PG8_STAGE(PG8_SB(0, 0), b2, voffB);
            PG8_BAR; PG8_WAIT_L(0); PG8_MMA(0, 1, At, B1); PG8_BAR;
            PG8_LDA(At, 0, 1); PG8_STAGE(PG8_SA(0, 0), a2, voffA);
            PG8_BAR; PG8_WAIT_L(0); PG8_MMA(1, 0, At, B0); PG8_BAR; PG8_SCHED;
            PG8_STAGE(PG8_SB(0, 1), b2 + hstep, voffB);
            PG8_WAIT_V(6); PG8_BAR; PG8_MMA(1, 1, At, B1); PG8_BAR;
            PG8_LDB(B0, 1, 0); PG8_SCHED; PG8_LDA(At, 1, 0); PG8_STAGE(PG8_SA(0, 1), a2 + hstep, voffA);
            PG8_WAIT_L(8); PG8_BAR; PG8_WAIT_L(0); PG8_MMA(0, 0, At, B0); PG8_BAR; PG8_SCHED;
            PG8_LDB(B1, 1, 1); PG8_STAGE(PG8_SB(1, 0), b3, voffB);
            PG8_BAR; PG8_WAIT_L(0); PG8_MMA(0, 1, At, B1); PG8_BAR;
            PG8_LDA(At, 1, 1); PG8_STAGE(PG8_SA(1, 0), a3, voffA);
            PG8_BAR; PG8_WAIT_L(0); PG8_MMA(1, 0, At, B0); PG8_BAR; PG8_SCHED;
            PG8_STAGE(PG8_SB(1, 1), b3 + hstep, voffB);
            PG8_WAIT_V(6); PG8_BAR; PG8_MMA(1, 1, At, B1); PG8_BAR;
            }
        }
        if constexpr (ALIGN_EPI) { if (wr == 0) PG8_BAR; }
        if constexpr (!Epi::AFTER_DRAIN) { if (cur.part != 1) E(acc, cur, wr, wc, fr, fq);
            S.done(cur); }
        if (!has_next) break;
        if (nxt.part != 2)
#pragma unroll
        for (int a = 0; a < 2; ++a)
#pragma unroll
            for (int b = 0; b < 2; ++b)
#pragma unroll
                for (int m = 0; m < 4; ++m)
#pragma unroll
                    for (int n = 0; n < 2; ++n) acc[a][b][m][n] = (f32x4){0.f, 0.f, 0.f, 0.f};
        cur = nxt; cA = nA; cB = nB; ++ui; nt = cur.nt;
        if constexpr (ALIGN_EPI) { if (wr == 1) PG8_BAR; }
    }
    PG8_WAIT_V(0);
    if constexpr (!ALIGN_EPI) { if (wr == 0) PG8_BAR; }
    PG8_BAR;
#undef PG8_SA
#undef PG8_SB
#undef PG8_STAGE
#undef PG8_LDA
#undef PG8_LDB
#undef PG8_MMA
#undef PG8_WAIT_V
#undef PG8_WAIT_L
#undef PG8_BAR
#undef PG8_SCHED
}
}

namespace att {
using bf16 = __hip_bfloat16;
constexpr int D = 128, NW = 8, QBLK = 32, KVBLK = 64;
constexpr float SCALE = 0.088388347648318440f;
constexpr float THR = 8.f;
constexpr int LDQ = QKVW, LDK = QKVW, LDO = 2048;
constexpr size_t SHM_V = KVBLK * D * 2, SHM_K = KVBLK * D * 2, SHM_ATTN = 2 * SHM_V + 2 * SHM_K + NW * 64 * 4;
using bf16x8 = __attribute__((ext_vector_type(8))) short;
using s16x4  = __attribute__((ext_vector_type(4))) short;
using f32x16 = __attribute__((ext_vector_type(16))) float;
using u32x4  = __attribute__((ext_vector_type(4))) unsigned;
#define KSWZ(row, colB) ((row) * 256 + ((colB) ^ (((row) & 7) << 4)))
#define SBAR() __builtin_amdgcn_sched_barrier(0)
__device__ __forceinline__ int crow(int r, int hi) { return (r & 3) + 8 * (r >> 2) + 4 * hi; }
__device__ __forceinline__ unsigned cvtpk(float lo, float hi) { unsigned r; asm volatile("v_cvt_pk_bf16_f32 %0, %1, %2" : "=v"(r) : "v"(lo), "v"(hi)); return r; }
__device__ __forceinline__ bf16x8 ld8(const bf16* p) { return *reinterpret_cast<const bf16x8*>(p); }

__device__ __forceinline__ void partialSM(f32x16& p0, f32x16& p1, float& m_reg, float& mn, float& alpha) {
  constexpr float C = SCALE * 1.4426950408889634f;
  float pmax = p0[0];
#pragma unroll
  for (int r = 1; r < 16; ++r) pmax = fmaxf(pmax, p0[r]);
#pragma unroll
  for (int r = 0; r < 16; ++r) pmax = fmaxf(pmax, p1[r]);
  { auto rr = __builtin_amdgcn_permlane32_swap(__float_as_uint(pmax), __float_as_uint(pmax), false, false);
    pmax = fmaxf(__uint_as_float(rr[0]), __uint_as_float(rr[1])); }
  if (__builtin_expect(__all(pmax - m_reg <= THR / SCALE), 1)) { mn = m_reg; alpha = 1.f; }
  else { mn = fmaxf(m_reg, pmax); alpha = __builtin_amdgcn_exp2f((m_reg - mn) * C); m_reg = mn; }
  float mnC = -mn * C;
#pragma unroll
  for (int r = 0; r < 16; ++r) p0[r] = fmaf(p0[r], C, mnC);
#pragma unroll
  for (int r = 0; r < 16; ++r) p1[r] = fmaf(p1[r], C, mnC);
#pragma unroll
  for (int r = 0; r < 16; ++r) p0[r] = __builtin_amdgcn_exp2f(p0[r]);
}
__device__ __forceinline__ void finishSM(f32x16& p0, f32x16& p1, float alpha, float& l_reg, bf16x8& pa0, bf16x8& pa1, bf16x8& pa2, bf16x8& pa3) {
#pragma unroll
  for (int r = 0; r < 16; ++r) p1[r] = __builtin_amdgcn_exp2f(p1[r]);
  float ps = 0;
#pragma unroll
  for (int r = 0; r < 16; ++r) ps += p0[r];
#pragma unroll
  for (int r = 0; r < 16; ++r) ps += p1[r];
  { auto rr = __builtin_amdgcn_permlane32_swap(__float_as_uint(ps), __float_as_uint(ps), false, false);
    ps = __uint_as_float(rr[0]) + __uint_as_float(rr[1]); }
  l_reg = l_reg * alpha + ps;
#define PK4(P, BASE, OUT) do { unsigned a0 = cvtpk(P[BASE + 0], P[BASE + 1]), a1 = cvtpk(P[BASE + 2], P[BASE + 3]);   \
    unsigned b0 = cvtpk(P[BASE + 4], P[BASE + 5]), b1 = cvtpk(P[BASE + 6], P[BASE + 7]);                              \
    auto r0 = __builtin_amdgcn_permlane32_swap(a0, b0, false, false); auto r1 = __builtin_amdgcn_permlane32_swap(a1, b1, false, false); \
    u32x4 w = {r0[0], r1[0], r0[1], r1[1]}; OUT = *reinterpret_cast<bf16x8*>(&w); } while (0)
  PK4(p0, 0, pa0); PK4(p0, 8, pa1); PK4(p1, 0, pa2); PK4(p1, 8, pa3);
#undef PK4
}
__device__ __forceinline__ void qkt(f32x16& p0, f32x16& p1, const bf16* Ks, const bf16x8* qr, int r32, int hi) {
  p0 = f32x16{}; p1 = f32x16{};
  bf16x8 kb[16];
#define KFRAG(d0_, h_) (*reinterpret_cast<const bf16x8*>((const char*)Ks + KSWZ((h_) * 32 + r32, ((d0_) * 16 + hi * 8) * 2)))
#pragma unroll
  for (int d0 = 0; d0 < 2; ++d0) { kb[2 * d0] = KFRAG(d0, 0); kb[2 * d0 + 1] = KFRAG(d0, 1); }
  SBAR();
#pragma unroll
  for (int d0 = 0; d0 < 8; ++d0) {
    p0 = __builtin_amdgcn_mfma_f32_32x32x16_bf16(kb[2 * d0], qr[d0], p0, 0, 0, 0);
    p1 = __builtin_amdgcn_mfma_f32_32x32x16_bf16(kb[2 * d0 + 1], qr[d0], p1, 0, 0, 0);
    if (d0 < 6) { kb[2 * (d0 + 2)] = KFRAG(d0 + 2, 0); kb[2 * (d0 + 2) + 1] = KFRAG(d0 + 2, 1); }
    SBAR();
  }
#undef KFRAG
}
__device__ __forceinline__ int v_st(int k, int c) { const int kk = (k & ~0xC) | ((k & 4) << 1) | ((k & 8) >> 1); return ((kk >> 3) * 4 + (c >> 5)) * 512 + ((kk & 7) * 32 + (c & 31)) * 2; }
__device__ __forceinline__ int v_rd_base(int lane) { return ((lane & 3) << 3) | (((lane >> 2) & 3) << 6) | (((lane >> 4) & 1) << 5) | (((lane >> 5) & 1) << 8); }
constexpr int v_rd_off(int d0, int ks, int half) { return d0 * 512 + ks * 4096 + half * 2048; }
template <int OFF> __device__ __forceinline__ s16x4 tr_read(int vb) {
  s16x4 r; asm volatile("ds_read_b64_tr_b16 %0, %1 offset:%2" : "=&v"(r) : "v"(vb), "i"(OFF) : "memory"); return r;
}
template <int D0> __device__ __forceinline__ void pv_one(f32x16& od, int vb, bf16x8 pa0, bf16x8 pa1, bf16x8 pa2, bf16x8 pa3) {
  const s16x4 l0 = tr_read<v_rd_off(D0, 0, 0)>(vb), h0 = tr_read<v_rd_off(D0, 0, 1)>(vb), l1 = tr_read<v_rd_off(D0, 1, 0)>(vb), h1 = tr_read<v_rd_off(D0, 1, 1)>(vb);
  const s16x4 l2 = tr_read<v_rd_off(D0, 2, 0)>(vb), h2 = tr_read<v_rd_off(D0, 2, 1)>(vb), l3 = tr_read<v_rd_off(D0, 3, 0)>(vb), h3 = tr_read<v_rd_off(D0, 3, 1)>(vb);
  asm volatile("s_waitcnt lgkmcnt(0)" ::: "memory"); SBAR();
#define PK(L, H) (bf16x8){L[0], L[1], L[2], L[3], H[0], H[1], H[2], H[3]}
  od = __builtin_amdgcn_mfma_f32_32x32x16_bf16(pa0, PK(l0, h0), od, 0, 0, 0);
  od = __builtin_amdgcn_mfma_f32_32x32x16_bf16(pa1, PK(l1, h1), od, 0, 0, 0);
  od = __builtin_amdgcn_mfma_f32_32x32x16_bf16(pa2, PK(l2, h2), od, 0, 0, 0);
  od = __builtin_amdgcn_mfma_f32_32x32x16_bf16(pa3, PK(l3, h3), od, 0, 0, 0);
#undef PK
}
__device__ __forceinline__ void pv_d0(f32x16* o, int vb, bf16x8 pa0, bf16x8 pa1, bf16x8 pa2, bf16x8 pa3) {
  pv_one<0>(o[0], vb, pa0, pa1, pa2, pa3); pv_one<1>(o[1], vb, pa0, pa1, pa2, pa3); pv_one<2>(o[2], vb, pa0, pa1, pa2, pa3); pv_one<3>(o[3], vb, pa0, pa1, pa2, pa3);
}
__device__ __forceinline__ unsigned pk4_fp8(float a, float b, float c, float d) { int w = __builtin_amdgcn_cvt_pk_fp8_f32(a, b, 0, false); w = __builtin_amdgcn_cvt_pk_fp8_f32(c, d, w, true); return (unsigned)w; }
constexpr int KB_BYTES = 8192, VB_BYTES = 16384, LDS_KOFF = 0, LDS_VOFF = 2 * KB_BYTES, LDS_WSOFF = 131072;
#define WAIT_BAR0() asm volatile("s_waitcnt vmcnt(0) lgkmcnt(0)\n\ts_barrier" ::: "memory")
typedef float f32x4 __attribute__((ext_vector_type(4)));
typedef int v8i __attribute__((ext_vector_type(8)));
typedef int v4i __attribute__((ext_vector_type(4)));
constexpr float THR8L = 4.328f;
__device__ __forceinline__ void attn_unit_v256(const unsigned char* __restrict__ Qb, const unsigned char* __restrict__ Kh, const unsigned char* __restrict__ Vh, float* Ob, int seq, char* lds,
                                               int mode, const float* O1b, unsigned short* AOb, float lam, const float* gain, float gmul, int wid0) {
  const int tid = opaque_tid(wid0), wid = __builtin_amdgcn_readfirstlane(tid >> 6), lane = tid & 63, r32 = lane & 31, hi = lane >> 5;
  typedef __attribute__((address_space(3))) unsigned char* lptr;
  const lptr l3 = (lptr)lds;
  float* ws = (float*)(lds + LDS_WSOFF) + wid * 64; float* li_l = ws; float* al_l = ws + 32;
  const char* kg = (const char*)Kh + wid * 1024 + lane * 16; const char* vg = (const char*)Vh + wid * 1024 + lane * 16;
#define LDSP(off_) ((__attribute__((address_space(3))) unsigned*)(l3 + (off_)))
#define DMA_TILE(t, kbuf, vbuf) do { const char* kt_ = kg + (size_t)(t) * KB_BYTES; const char* vt_ = vg + (size_t)(t) * VB_BYTES; \
      __builtin_amdgcn_global_load_lds((const unsigned*)kt_, LDSP(LDS_KOFF + (kbuf) * KB_BYTES + wid * 1024), 16, 0, 0); \
      __builtin_amdgcn_global_load_lds((const unsigned*)vt_, LDSP(LDS_VOFF + (vbuf) * VB_BYTES + wid * 1024), 16, 0, 0); \
      __builtin_amdgcn_global_load_lds((const unsigned*)(vt_ + 8192), LDSP(LDS_VOFF + (vbuf) * VB_BYTES + 8192 + wid * 1024), 16, 0, 0); } while (0)
  DMA_TILE(0, 0, 0);
  float m_reg = 0.f, l_reg = 0; f32x16 o[8] = {};
  v8i qf[2];
  { const unsigned char* Qw = Qb + (size_t)(wid * QBLK + r32) * DM + hi * 32;
#pragma unroll
    for (int ds = 0; ds < 2; ++ds) { const v4i a = *(const v4i*)(Qw + ds * 64), b = *(const v4i*)(Qw + ds * 64 + 16); qf[ds] = (v8i){a[0], a[1], a[2], a[3], b[0], b[1], b[2], b[3]}; } }
  int kb_l = LDS_KOFF + lane * 16; asm volatile("" : "+v"(kb_l));
  int vb_l = LDS_VOFF + lane * 16; asm volatile("" : "+v"(vb_l));
#define RESC8(a) do { if (__any((a) < 1.f)) { if (hi == 0) al_l[r32] = (a); asm volatile("s_waitcnt lgkmcnt(0)" ::: "memory"); \
    _Pragma("unroll") for (int d = 0; d < 8; ++d) _Pragma("unroll") for (int r = 0; r < 16; ++r) o[d][r] *= al_l[crow(r, hi)]; } } while (0)
#define LD16(off_) (*(const __attribute__((address_space(3))) v4i*)(l3 + (off_)))
#define CAT8(a_, b_) ((v8i){a_[0], a_[1], a_[2], a_[3], b_[0], b_[1], b_[2], b_[3]})
  f32x16 p0, p1; float al; const int NT = seq / KVBLK;
#define ATT_TOP(j_, SL) do { WAIT_BAR0(); if ((j_) + 1 < NT) DMA_TILE((j_) + 1, ((SL) + 1) & 1, ((SL) + 1) & 3); } while (0)
#define ATT_QK(KS) do { \
    const int kbase = kb_l + (KS) * KB_BYTES; \
    f32x16 bt;                            \
    { const float base = 4.0f - m_reg; \
_Pragma("unroll") \
      for (int r = 0; r < 16; ++r) bt[r] = base; } \
    { const v4i a = LD16(kbase + ((0 * 2 + 0) * 2 + 0) * 1024), b = LD16(kbase + ((0 * 2 + 0) * 2 + 1) * 1024); \
      p0 = __builtin_amdgcn_mfma_scale_f32_32x32x64_f8f6f4(CAT8(a, b), qf[0], bt, 0, 0, 0, 0, 0, 0); } \
    { const v4i a = LD16(kbase + ((1 * 2 + 0) * 2 + 0) * 1024), b = LD16(kbase + ((1 * 2 + 0) * 2 + 1) * 1024); \
      p1 = __builtin_amdgcn_mfma_scale_f32_32x32x64_f8f6f4(CAT8(a, b), qf[0], bt, 0, 0, 0, 0, 0, 0); } \
    { const v4i a = LD16(kbase + ((0 * 2 + 1) * 2 + 0) * 1024), b = LD16(kbase + ((0 * 2 + 1) * 2 + 1) * 1024); \
      p0 = __builtin_amdgcn_mfma_scale_f32_32x32x64_f8f6f4(CAT8(a, b), qf[1], p0, 0, 0, 0, 0, 0, 0); } \
    { const v4i a = LD16(kbase + ((1 * 2 + 1) * 2 + 0) * 1024), b = LD16(kbase + ((1 * 2 + 1) * 2 + 1) * 1024); \
      p1 = __builtin_amdgcn_mfma_scale_f32_32x32x64_f8f6f4(CAT8(a, b), qf[1], p1, 0, 0, 0, 0, 0, 0); } } while (0)
#define ATT_SM(j_, PF) do { \
    float ps; al = 1.f; \
    if ((j_) == 0) {                      \
      float pmax = p0[0]; \
_Pragma("unroll") \
      for (int r = 1; r < 16; ++r) pmax = fmaxf(pmax, p0[r]); \
_Pragma("unroll") \
      for (int r = 0; r < 16; ++r) pmax = fmaxf(pmax, p1[r]); \
      { auto rr = __builtin_amdgcn_permlane32_swap(__float_as_uint(pmax), __float_as_uint(pmax), false, false); \
        pmax = fmaxf(__uint_as_float(rr[0]), __uint_as_float(rr[1])); } \
      const float dl = pmax - 4.0f; \
_Pragma("unroll") \
      for (int r = 0; r < 16; ++r) { p0[r] -= dl; p1[r] -= dl; } \
      m_reg += dl; ps = 0.f; \
_Pragma("unroll") \
      for (int r = 0; r < 16; ++r) { p0[r] = __builtin_amdgcn_exp2f(p0[r]); ps += p0[r]; } \
_Pragma("unroll") \
      for (int r = 0; r < 16; ++r) { p1[r] = __builtin_amdgcn_exp2f(p1[r]); ps += p1[r]; } \
    } else { float pa = 0.f, pb = 0.f; \
_Pragma("unroll") \
      for (int r = 0; r < 16; ++r) { p0[r] = __builtin_amdgcn_exp2f(p0[r]); pa += p0[r]; } \
      asm volatile("" : "+v"(pa));          \
_Pragma("unroll") \
      for (int r = 0; r < 16; ++r) { p1[r] = __builtin_amdgcn_exp2f(p1[r]); pb += p1[r]; } \
      ps = pa + pb; \
      if (__builtin_expect(__any(fmaxf(pa, pb) > 448.f), 0)) {        \
        float pmax = p0[0]; \
_Pragma("unroll") \
        for (int r = 1; r < 16; ++r) pmax = fmaxf(pmax, p0[r]); \
_Pragma("unroll") \
        for (int r = 0; r < 16; ++r) pmax = fmaxf(pmax, p1[r]); \
        { auto rr = __builtin_amdgcn_permlane32_swap(__float_as_uint(pmax), __float_as_uint(pmax), false, false); \
          pmax = fmaxf(__uint_as_float(rr[0]), __uint_as_float(rr[1])); } \
        const float dl = fmaxf(fminf(__builtin_amdgcn_logf(pmax), 126.f) - 4.0f, 0.f); \
        al = __builtin_amdgcn_exp2f(-dl); \
_Pragma("unroll") \
        for (int r = 0; r < 16; ++r) { p0[r] = fminf(p0[r] * al, 448.f); p1[r] = fminf(p1[r] * al, 448.f); }        \
        ps = 0.f; \
_Pragma("unroll") \
        for (int r = 0; r < 16; ++r) ps += p0[r] + p1[r]; \
        m_reg += dl; } } \
    { auto rr = __builtin_amdgcn_permlane32_swap(__float_as_uint(ps), __float_as_uint(ps), false, false); \
      ps = __uint_as_float(rr[0]) + __uint_as_float(rr[1]); } \
    l_reg = l_reg * al + ps; \
_Pragma("unroll") \
    for (int w = 0; w < 4; ++w) { PF[w] = (int)pk4_fp8(p0[4 * w], p0[4 * w + 1], p0[4 * w + 2], p0[4 * w + 3]); PF[4 + w] = (int)pk4_fp8(p1[4 * w], p1[4 * w + 1], p1[4 * w + 2], p1[4 * w + 3]); } \
    RESC8(al); } while (0)
#define ATT_PV(PF, VS) do { \
    const int vbase = vb_l + (VS) * VB_BYTES; \
_Pragma("unroll") \
    for (int cb = 0; cb < 8; ++cb) { const v4i a = LD16(vbase + cb * 2048), b = LD16(vbase + cb * 2048 + 1024); \
      o[cb] = __builtin_amdgcn_mfma_scale_f32_32x32x64_f8f6f4(PF, CAT8(a, b), o[cb], 0, 0, 0, 0, 0, 0); } } while (0)
#define STEP_A(j_, SL) do { ATT_TOP(j_, SL); v8i pf; ATT_QK((SL) & 1); ATT_SM(j_, pf); ATT_PV(pf, SL); } while (0)
#define STEP_B(j_, SL) do { ATT_TOP(j_, SL); if ((j_) > 0) ATT_PV(pfb, ((SL) + 3) & 3); ATT_QK((SL) & 1); ATT_SM(j_, pfb); } while (0)
  if (wid < 4) {
    __builtin_amdgcn_s_setprio(1);
    for (int j = 0; j < NT; j += 4) { STEP_A(j, 0); STEP_A(j + 1, 1); STEP_A(j + 2, 2); STEP_A(j + 3, 3); }
  } else {
    v8i pfb = {};
    for (int j = 0; j < NT; j += 4) { STEP_B(j, 0); STEP_B(j + 1, 1); STEP_B(j + 2, 2); STEP_B(j + 3, 3); }
    ATT_PV(pfb, 3);
  }
#undef STEP_A
#undef STEP_B
#undef ATT_TOP
#undef ATT_QK
#undef ATT_SM
#undef ATT_PV
#undef LD16
#undef CAT8
  __builtin_amdgcn_s_setprio(0);
  if (hi == 0) li_l[r32] = l_reg; asm volatile("s_waitcnt lgkmcnt(0)" ::: "memory");
  float rli[16];
#pragma unroll
  for (int r = 0; r < 16; ++r) rli[r] = __builtin_amdgcn_rcpf(li_l[crow(r, hi)]);
#pragma unroll
  for (int d0 = 0; d0 < 8; ++d0) {
#pragma unroll
    for (int r = 0; r < 16; ++r) o[d0][r] *= rli[r];
    asm volatile("" : "+v"(o[d0])); }
  if (mode == 0) {
    f32x4* On = (f32x4*)Ob + wid * 2048 + lane;
#pragma unroll
    for (int d0 = 0; d0 < 8; ++d0)
#pragma unroll
      for (int rq = 0; rq < 4; ++rq) On[(d0 * 4 + rq) * 64] = (f32x4){o[d0][4 * rq], o[d0][4 * rq + 1], o[d0][4 * rq + 2], o[d0][4 * rq + 3]};
  } else {
    const f32x4* On = (const f32x4*)O1b + wid * 2048 + lane; float ssq[16];
#pragma unroll
    for (int r = 0; r < 16; ++r) ssq[r] = 0.f;
#define LD4SC1(dst, ptr) asm volatile("global_load_dwordx4 %0, %1, off sc1" : "=v"(dst) : "v"(ptr) : "memory")
#pragma unroll
    for (int d0 = 0; d0 < 8; d0 += 2) { f32x4 t[2][4];
#pragma unroll
      for (int dd = 0; dd < 2; ++dd)
#pragma unroll
        for (int rq = 0; rq < 4; ++rq) LD4SC1(t[dd][rq], On + ((d0 + dd) * 4 + rq) * 64);
      asm volatile("s_waitcnt vmcnt(0)" : "+v"(t[0][0]), "+v"(t[0][1]), "+v"(t[0][2]), "+v"(t[0][3]), "+v"(t[1][0]), "+v"(t[1][1]), "+v"(t[1][2]), "+v"(t[1][3]) :: "memory");
#pragma unroll
      for (int dd = 0; dd < 2; ++dd)
#pragma unroll
        for (int rq = 0; rq < 4; ++rq)
#pragma unroll
          for (int i = 0; i < 4; ++i) { const float d = t[dd][rq][i] - lam * o[d0 + dd][4 * rq + i]; ssq[4 * rq + i] += d * d; } }
#pragma unroll
    for (int r = 0; r < 16; ++r) { float v = ssq[r];
      v = half_sum32(v);
      ssq[r] = 1.0f / sqrtf(v * (1.f / 256.f) + 1e-6f); }
    unsigned short* Aw = AOb + (long)(wid * QBLK + 4 * hi) * 2048 + r32;
#pragma unroll
    for (int d0 = 0; d0 < 8; d0 += 2) { f32x4 t[2][4];
#pragma unroll
      for (int dd = 0; dd < 2; ++dd)
#pragma unroll
        for (int rq = 0; rq < 4; ++rq) LD4SC1(t[dd][rq], On + ((d0 + dd) * 4 + rq) * 64);
      asm volatile("s_waitcnt vmcnt(0)" : "+v"(t[0][0]), "+v"(t[0][1]), "+v"(t[0][2]), "+v"(t[0][3]), "+v"(t[1][0]), "+v"(t[1][1]), "+v"(t[1][2]), "+v"(t[1][3]) :: "memory");
#pragma unroll
      for (int dd = 0; dd < 2; ++dd) { const float gl = gain[(d0 + dd) * 32 + r32] * gmul;
#pragma unroll
        for (int rq = 0; rq < 4; ++rq)
#pragma unroll
          for (int i = 0; i < 4; ++i) { const int r = 4 * rq + i;
            Aw[(long)(i + 8 * rq) * 2048 + (d0 + dd) * 32] = (unsigned short)(cvtpk((t[dd][rq][i] - lam * o[d0 + dd][r]) * ssq[r] * gl, 0.f) & 0xffffu); } } }
#undef LD4SC1
  }
  WAIT_BAR0();
#undef DMA_TILE
#undef LDSP
#undef RESC8
}
#undef WAIT_BAR0
#undef KSWZ
#undef SBAR
}

constexpr size_t MiB = 1u << 20;
constexpr size_t WS_CTL = 0, CTL_ZERO_BYTES = 64 * 1024;
constexpr size_t WS_MOD = 1 * MiB;
constexpr size_t WS_ROPE = 2 * MiB;
constexpr size_t WS_WQKV = 4 * MiB;
constexpr size_t WS_WO = WS_WQKV + 48 * MiB;
constexpr size_t WS_WIN = WS_WO + 16 * MiB;
constexpr size_t WS_WOUT = WS_WIN + 48 * MiB;
constexpr size_t WS_WUP = WS_WOUT + 16 * MiB;
constexpr size_t WS_WDN = WS_WUP + 176 * MiB;
constexpr size_t WS_X = WS_WDN + 88 * MiB;
constexpr size_t WS_H = WS_X + 132 * MiB;
constexpr size_t WS_C = WS_H + 66 * MiB;
constexpr size_t WS_QKV = WS_C;
constexpr size_t WS_OP = WS_C + 198 * MiB;
constexpr size_t WS_KT = WS_OP + 132 * MiB;
constexpr size_t WS_VT = WS_KT + 66 * MiB;
constexpr size_t WS_Y = WS_C;
constexpr size_t WS_ACT = WS_C + 363 * MiB;
constexpr size_t WS_YE = WS_ACT + 182 * MiB;
constexpr size_t WS_SLAB = WS_YE + 12 * MiB;
constexpr size_t WS_PE = WS_SLAB + 16 * MiB;
constexpr size_t WS_END = WS_PE + 4 * MiB;
static_assert((size_t)R * UPW * 2 <= 363 * MiB && (size_t)R * DFF * 2 <= 182 * MiB && (size_t)R * 4096 * 4 <= 264 * MiB && (size_t)R * QKVW * 2 <= 198 * MiB, "ws map");
static_assert(WS_OP + 264 * MiB <= WS_END, "ws map");

constexpr int CW_BAR = 1024;

constexpr int RING_BYTES = 131072;
constexpr int LDS_BYTES = 147456;
constexpr int MISC_OFF = 146432;

#define GAS __attribute__((address_space(1)))
#define LAS __attribute__((address_space(3)))
typedef unsigned short bf16r;
typedef unsigned v4u __attribute__((ext_vector_type(4)));
typedef unsigned v2u __attribute__((ext_vector_type(2)));
typedef float f32x4 __attribute__((ext_vector_type(4)));
typedef GAS unsigned gu32;
#define RLX_AGENT __ATOMIC_RELAXED, __HIP_MEMORY_SCOPE_AGENT
__device__ __forceinline__ unsigned pk2(float lo, float hi) { unsigned r; asm volatile("v_cvt_pk_bf16_f32 %0, %1, %2" : "=v"(r) : "v"(lo), "v"(hi)); return r; }
__device__ __forceinline__ float bf_lo(unsigned w) { return __uint_as_float(w << 16); }
__device__ __forceinline__ float bf_hi(unsigned w) { return __uint_as_float(w & 0xffff0000u); }
__device__ __forceinline__ float wave_sum(float v) {
    v = half_sum32(v);
    const auto rr = __builtin_amdgcn_permlane32_swap(__float_as_uint(v), __float_as_uint(v), false, false);
    return __uint_as_float(rr[0]) + __uint_as_float(rr[1]);
}

#define XB_TMO      128
#define XB_XCNT(j)  (256  + 64 * (j))
#define XB_XSUB(j)  (1280 + 64 * (j))
#define XB_XGEN(j)  (2304 + 64 * (j))
#define XB_TOP      3328
#define XB_TOPGEN   3392
#define XCD_BAR_WORDS 3456
#define XB_SPIN_CAP (1u << 18)
__device__ __forceinline__ unsigned xb_ld(unsigned* p)              { return __hip_atomic_load(p, __ATOMIC_RELAXED, __HIP_MEMORY_SCOPE_AGENT); }
__device__ __forceinline__ unsigned xb_add(unsigned* p, unsigned v) { return __hip_atomic_fetch_add(p, v, __ATOMIC_RELAXED, __HIP_MEMORY_SCOPE_AGENT); }
__device__ __forceinline__ unsigned xb_xcc_id() { return (unsigned)__builtin_amdgcn_s_getreg((3 << 11) | 20) & 0xFu; }
#define XB_SPIN(cond, bar) do { unsigned _sp = 0; while (cond) { __builtin_amdgcn_s_sleep(1); \
    if ((++_sp & 255u) == 0u) { if (xb_ld(&(bar)[XB_TMO])) break; if (_sp > XB_SPIN_CAP) { atomicAdd(&(bar)[XB_TMO], 1u); break; } } } } while (0)
struct XcdBarrier { unsigned* bar; unsigned x; volatile LAS unsigned* st; };
__device__ __forceinline__ XcdBarrier xcd_barrier_post(unsigned* bar, volatile LAS unsigned* st) {
    XcdBarrier b; b.bar = bar; b.x = xb_xcc_id(); b.st = st;
    if (threadIdx.x == 0) (void)xb_add(&bar[XB_XCNT(b.x)], 1u);
    return b;
}
__device__ __forceinline__ void xcd_barrier_complete(unsigned* bar, unsigned x, unsigned& nloc, unsigned& nx) {
    const unsigned G = gridDim.x * gridDim.y * gridDim.z;
    unsigned sum, cnt, mine, sp = 0u;
    for (;;) {
        sum = 0u; cnt = 0u; mine = 0u;
#pragma unroll
        for (unsigned j = 0; j < 16; ++j) { const unsigned c = xb_ld(&bar[XB_XCNT(j)]); sum += c; cnt += (c > 0u) ? 1u : 0u; }
        if (sum == G) { mine = xb_ld(&bar[XB_XCNT(x)]); break; }
        __builtin_amdgcn_s_sleep(1);
        if ((++sp & 255u) == 0u) { if (xb_ld(&bar[XB_TMO])) break; if (sp > XB_SPIN_CAP) { atomicAdd(&bar[XB_TMO], 1u); break; } }
    }
    nloc = mine > 0u ? mine : 1u; nx = cnt > 0u ? cnt : 1u;
}
__device__ __forceinline__ void xcd_barrier(const XcdBarrier& b) {
    asm volatile("s_waitcnt vmcnt(0)" ::: "memory");
    __syncthreads();
    if (threadIdx.x == 0) {
        unsigned* bar = b.bar; unsigned bx = b.x;
        asm volatile("" : "+s"(bx));
        __builtin_amdgcn_s_waitcnt(0);
        unsigned nloc = b.st[0], nx = b.st[1];
        if (nloc == 0u) { xcd_barrier_complete(bar, bx, nloc, nx); b.st[0] = nloc; b.st[1] = nx; }
        const unsigned old = xb_add(&bar[XB_XSUB(bx)], 1u);
        const unsigned gen = old / nloc;
        if (old + 1u == (gen + 1u) * nloc) {
            __builtin_amdgcn_fence(__ATOMIC_RELEASE, "agent");
            asm volatile("s_waitcnt vmcnt(0)" ::: "memory");
            const unsigned og = xb_add(&bar[XB_TOP], 1u);
            const unsigned tg = og / nx;
            if (og + 1u == (tg + 1u) * nx) xb_add(&bar[XB_TOPGEN], 1u);
            else XB_SPIN(xb_ld(&bar[XB_TOPGEN]) == tg, bar);
            __builtin_amdgcn_fence(__ATOMIC_ACQUIRE, "agent");
            xb_add(&bar[XB_XGEN(bx)], 1u);
            asm volatile("s_waitcnt vmcnt(0)" ::: "memory");
        } else {
            XB_SPIN(xb_ld(&bar[XB_XGEN(bx)]) == gen, bar);
            __builtin_amdgcn_fence(__ATOMIC_ACQUIRE, "agent");
            asm volatile("s_waitcnt vmcnt(0)" ::: "memory");
        }
    }
    __syncthreads();
}

struct Args { const float* in[20]; float* out; unsigned char* ws; int ph_lo, ph_hi; };
struct Frame {
    LAS unsigned char* lds;
    int wid0;
    int tid, lane, wave;
    int vcu, G;
    const Args* a;
    unsigned char* ws;
};
#define REFRESH(F) do { (F).tid = opaque_tid((F).wid0); (F).lane = (F).tid & 63; (F).wave = __builtin_amdgcn_readfirstlane((F).tid >> 6); } while (0)
#define FIN(k) (F.a->in[k])
#define F_x FIN(0)
#define F_c FIN(1)
#define F_ctx FIN(2)
#define F_c_ctx FIN(3)
#define F_w_ada FIN(4)
#define F_b_ada FIN(5)
#define F_w_qkv FIN(6)
#define F_w_o FIN(7)
#define F_lq1 FIN(8)
#define F_lk1 FIN(9)
#define F_lq2 FIN(10)
#define F_lk2 FIN(11)
#define F_subln FIN(12)
#define F_w_in FIN(13)
#define F_sconv FIN(14)
#define F_w_out FIN(15)
#define F_w_up FIN(16)
#define F_fconv FIN(17)
#define F_w_dn FIN(18)
#define F_fgain FIN(19)
#define F_out (F.a->out)
#define F_MOD ((float*)(F.ws + WS_MOD))
#define F_ROPE ((float*)(F.ws + WS_ROPE))
#define F_X ((float*)(F.ws + WS_X))
#define F_OP ((float*)(F.ws + WS_OP))
#define F_KT ((bf16r*)(F.ws + WS_KT))
#define F_VT ((bf16r*)(F.ws + WS_VT))
#define F_WQKV ((bf16r*)(F.ws + WS_WQKV))
#define F_WO ((bf16r*)(F.ws + WS_WO))
#define F_WIN ((bf16r*)(F.ws + WS_WIN))
#define F_WOUT ((bf16r*)(F.ws + WS_WOUT))
#define F_WUP ((bf16r*)(F.ws + WS_WUP))
#define F_WDN ((bf16r*)(F.ws + WS_WDN))
#define F_H ((bf16r*)(F.ws + WS_H))
#define F_QKV ((bf16r*)(F.ws + WS_QKV))
#define F_Y ((bf16r*)(F.ws + WS_Y))
#define F_ACT ((bf16r*)(F.ws + WS_ACT))
#define F_YE ((float*)(F.ws + WS_YE))
#define F_SLAB ((float*)(F.ws + WS_C))
#define F_PE ((float*)(F.ws + WS_PE))
#define F_YS ((float*)(F.ws + WS_C))
#define F_XST ((float*)(F.ws + WS_PE + 3 * MiB))
#define F_GB ((bf16r*)(F.ws + WS_QKV))
#define F_CZ ((bf16r*)(F.ws + WS_QKV + 66 * MiB))

__device__ __forceinline__ unsigned pk4f8(float a, float b, float c, float d) { int w = __builtin_amdgcn_cvt_pk_fp8_f32(a, b, 0, false); w = __builtin_amdgcn_cvt_pk_fp8_f32(c, d, w, true); return (unsigned)w; }
__device__ __forceinline__ void p0_transpose_item(const float* W, int K, int N, bf16r* WT, int permk, LAS float* scr, int item, int lane, bool fp8out = false) {
    const int nblk = N / 64, kb = item / nblk, nb = item % nblk, k0 = 64 * kb, n0 = 64 * nb;
    const float* src = W + (size_t)(k0 + (lane >> 4)) * N + n0 + 4 * (lane & 15);
    LAS float* sdst = scr + (lane >> 4) * 65 + 4 * (lane & 15);
#pragma unroll
    for (int h = 0; h < 2; ++h) { f32x4 v[8];
#pragma unroll
        for (int i = 0; i < 8; ++i) v[i] = *(const GAS f32x4*)(src + (size_t)(4 * (8 * h + i)) * N);
#pragma unroll
        for (int i = 0; i < 8; ++i) { LAS float* d = sdst + 4 * (8 * h + i) * 65; d[0] = v[i].x; d[1] = v[i].y; d[2] = v[i].z; d[3] = v[i].w; } }
    asm volatile("s_waitcnt lgkmcnt(0)" ::: "memory");
    const int c = lane & 7;
    const bool il = (permk == 1) && (n0 < 4096);
    int db = n0;
    if (permk == 2) { const bool isv = n0 >= DFF; const int c0 = isv ? n0 - DFF : n0; db = (c0 >> 7) * 256 + (c0 & 127) + (isv ? 128 : 0); }
    if (permk == 3) { if (n0 < DM) db = 2 * DM + n0; else { const bool isx = n0 >= 2 * DM; const int c0 = n0 - (isx ? 2 * DM : DM); db = (c0 >> 7) * 256 + (c0 & 127) + (isx ? 128 : 0); } }
#pragma unroll
    for (int j = 0; j < 8; ++j) { const int n = (lane >> 3) + 8 * j; const LAS float* s = scr + (8 * c) * 65 + n;
        v4u o; o.x = pk2(s[0 * 65], s[1 * 65]); o.y = pk2(s[2 * 65], s[3 * 65]); o.z = pk2(s[4 * 65], s[5 * 65]); o.w = pk2(s[6 * 65], s[7 * 65]);
        const int nd = il ? (2 * (n & 31) + (n >> 5)) : n;
        if (fp8out) { constexpr float WS = 64.f;
            v2u o8; o8.x = pk4f8(WS * s[0 * 65], WS * s[1 * 65], WS * s[2 * 65], WS * s[3 * 65]); o8.y = pk4f8(WS * s[4 * 65], WS * s[5 * 65], WS * s[6 * 65], WS * s[7 * 65]);
            *(GAS v2u*)((unsigned char*)WT + (size_t)(db + nd) * K + k0 + 8 * c) = o8;
            if (permk == 1 && n0 >= 4096) {
                float r[8];
#pragma unroll
                for (int q = 0; q < 8; ++q) r[q] = WS * s[q * 65] - __builtin_amdgcn_cvt_f32_fp8((int)((q < 4 ? o8.x : o8.y) >> (8 * (q & 3))), 0);
                v2u l8; l8.x = pk4f8(r[0], r[1], r[2], r[3]); l8.y = pk4f8(r[4], r[5], r[6], r[7]);
                *(GAS v2u*)((unsigned char*)WT + (size_t)(db + nd + 2048) * K + k0 + 8 * c) = l8; } }
        else *(GAS v4u*)(WT + (size_t)(db + nd) * K + k0 + 8 * c) = o; }
    asm volatile("s_waitcnt lgkmcnt(0)" ::: "memory");
}
typedef float f32x3u __attribute__((ext_vector_type(3), aligned(4)));
__device__ __forceinline__ void p0_prologue(Frame& F) {
    REFRESH(F);
    {
        LAS float* ssl = (LAS float*)F.lds;
        LAS float* red = (LAS float*)(F.lds + 24576);
        for (int idx = F.tid; idx < 3 * DM; idx += NWAVES * 64) { const int set = idx / DM, k = idx % DM; const float v = (set < 2) ? F_c[set * DM + k] : F_c_ctx[k]; ssl[idx] = v / (1.f + __expf(-v)); }
        __syncthreads();
        for (int item = blockIdx.x; item < 256; item += F.G) {
            const int layer = item >> 6, chunk = item & 63, n0 = chunk * 192;
            const float* Wp = F_w_ada + (size_t)layer * DM * NMODW + n0 + 3 * F.lane;
            float acc[3][3];
#pragma unroll
            for (int s = 0; s < 3; ++s)
#pragma unroll
                for (int j = 0; j < 3; ++j) acc[s][j] = 0.f;
            const int kbeg = F.wave * 256;
            for (int k = kbeg; k < kbeg + 256; k += 8) {
                f32x3u w[8];
#pragma unroll
                for (int q = 0; q < 8; ++q) w[q] = *(const f32x3u*)(Wp + (size_t)(k + q) * NMODW);
#pragma unroll
                for (int q = 0; q < 8; ++q) { const float s0 = ssl[k + q], s1 = ssl[DM + k + q], s2 = ssl[2 * DM + k + q];
#pragma unroll
                    for (int j = 0; j < 3; ++j) { acc[0][j] += s0 * w[q][j]; acc[1][j] += s1 * w[q][j]; acc[2][j] += s2 * w[q][j]; } }
            }
#pragma unroll
            for (int s = 0; s < 3; ++s)
#pragma unroll
                for (int j = 0; j < 3; ++j) red[(F.wave * 9 + s * 3 + j) * 64 + F.lane] = acc[s][j];
            __syncthreads();
            for (int idx = F.tid; idx < 9 * 64; idx += NWAVES * 64) { const int q = idx >> 6, l = idx & 63, set = q / 3, j = q % 3; float sum = 0.f;
#pragma unroll
                for (int w = 0; w < 8; ++w) sum += red[(w * 9 + q) * 64 + l];
                const int col = n0 + 3 * l + j;
                F_MOD[(size_t)(layer * 3 + set) * NMODW + col] = sum + F_b_ada[layer * NMODW + col]; }
            __syncthreads();
        }
    }
    const int gw = F.vcu * NWAVES + F.wave, NGW = F.G * NWAVES;
    {
        LAS float* scr = (LAS float*)(F.lds + F.wave * 16640);
        constexpr int I_QKV = 32 * 96, I_SQ = 32 * 32, I_UP = 32 * 176, I_DN = 88 * 32;
        constexpr int E0 = 2 * I_QKV, E1 = E0 + 2 * I_SQ, E2 = E1 + 2 * I_QKV, E3 = E2 + 2 * I_SQ, E4 = E3 + 4 * I_UP, E5 = E4 + 4 * I_DN;
        for (int it = gw; it < E5; it += NGW) {
            if (it < E0) { const int m = it / I_QKV, r = it % I_QKV; p0_transpose_item(F_w_qkv + (size_t)m * DM * QKVW, DM, QKVW, (bf16r*)((unsigned char*)F_WQKV + (size_t)m * 8192 * DM), 1, scr, r, F.lane, true);   }
            else if (it < E1) { const int q = it - E0, m = q / I_SQ, r = q % I_SQ; p0_transpose_item(F_w_o + (size_t)m * DM * DM, DM, DM, F_WO + (size_t)m * DM * DM, 0, scr, r, F.lane); }
            else if (it < E2) { const int q = it - E1, m = q / I_QKV, r = q % I_QKV; p0_transpose_item(F_w_in + (size_t)m * DM * QKVW, DM, QKVW, F_WIN + (size_t)m * QKVW * DM, 3, scr, r, F.lane); }
            else if (it < E3) { const int q = it - E2, m = q / I_SQ, r = q % I_SQ; p0_transpose_item(F_w_out + (size_t)m * DM * DM, DM, DM, F_WOUT + (size_t)m * DM * DM, 0, scr, r, F.lane); }
            else if (it < E4) { const int q = it - E3, m = q / I_UP, r = q % I_UP; p0_transpose_item(F_w_up + (size_t)m * DM * UPW, DM, UPW, F_WUP + (size_t)m * UPW * DM, 2, scr, r, F.lane); }
            else { const int q = it - E4, m = q / I_DN, r = q % I_DN; p0_transpose_item(F_w_dn + (size_t)m * DFF * DM, DFF, DM, F_WDN + (size_t)m * DM * DFF, 0, scr, r, F.lane); }
        }
    }
    {
        const int gt = gw * 64 + F.lane;
        if (gt < 128 * 32) { const int pos = gt >> 5, f = gt & 31; const float angf = (float)pos * INV_FREQ[f]; const double a = (double)angf;
            const double TWO_PI = 6.283185307179586476925286766559; double r = a - TWO_PI * __builtin_rint(a / TWO_PI);
            const double r2 = r * r; double sn = 0.0, cs = 0.0;
            double ts = r, tc = 1.0;
#pragma unroll 1
            for (int i = 0; i < 14; ++i) { cs += tc; sn += ts; tc = -tc * r2 / (double)((2 * i + 1) * (2 * i + 2)); ts = -ts * r2 / (double)((2 * i + 2) * (2 * i + 3)); }
            F_ROPE[2 * gt] = (float)cs; F_ROPE[2 * gt + 1] = (float)sn; }
    }
}

__device__ __forceinline__ const float* norm_src(Frame& F, int u, bool from_input) {
    if (from_input) { const int b = u / ROWS_B, w = u % ROWS_B; return (w < SEQ) ? F_x + (size_t)(b * SEQ + w) * DM : F_ctx + (size_t)(b * CTXL + (w - SEQ)) * DM; }
    return F_X + (size_t)u * DM;
}
__device__ __forceinline__ void norm_mod_phase(Frame& F, int layer, int which, bool skip_ctx, bool from_input = false, int nslab = 0, bool ctx_from_input = false, bool fp8out = false) {
    REFRESH(F);
    const int gw = F.vcu * NWAVES + F.wave, NGW = F.G * NWAVES;
    f32x4 v[8], vn[8];
    if (gw < R) { const GAS f32x4* xr = (const GAS f32x4*)norm_src(F, gw, from_input || (ctx_from_input && (gw % ROWS_B) >= SEQ)) + F.lane;
#pragma unroll
        for (int j = 0; j < 8; ++j) v[j] = xr[64 * j]; }
    for (int u = gw; u < R; u += NGW) {
        const int un = u + NGW;
        if (un < R) { const GAS f32x4* xr = (const GAS f32x4*)norm_src(F, un, from_input || (ctx_from_input && (un % ROWS_B) >= SEQ)) + F.lane;
#pragma unroll
            for (int j = 0; j < 8; ++j) vn[j] = xr[64 * j]; }
        const int pan = u >> 8, pp = pan % PAN_B;
        if (!(skip_ctx && pp == 32)) {
            const int set = (pp == 32) ? 2 : pan / PAN_B;
            const float* sh = F_MOD + (size_t)(layer * 3 + set) * NMODW + (which ? 3 : 0) * DM; const float* sc = sh + DM;
            float ss = 0.f;
            if (nslab > 0 && pp == 32) {
                const int cr = (pan / PAN_B) * 256 + (u & 255);
                for (int k = 0; k < nslab; ++k) { const GAS f32x4* sp = (const GAS f32x4*)(F_SLAB + ((size_t)k * 512 + cr) * DM) + F.lane;
#pragma unroll
                    for (int j = 0; j < 8; ++j) v[j] += sp[64 * j]; }
                GAS f32x4* xw = (GAS f32x4*)(F_X + (size_t)u * DM) + F.lane;
#pragma unroll
                for (int j = 0; j < 8; ++j) xw[64 * j] = v[j]; }
#pragma unroll
            for (int j = 0; j < 8; ++j) ss += (v[j].x * v[j].x + v[j].y * v[j].y) + (v[j].z * v[j].z + v[j].w * v[j].w);
            const float rstd = 1.0f / sqrtf(wave_sum(ss) * (1.f / DM) + EPS);
            GAS v2u* o8 = (GAS v2u*)(F_H + (size_t)u * DM) + F.lane; GAS unsigned* o4 = (GAS unsigned*)((unsigned char*)F_H + (size_t)u * DM) + F.lane;
#pragma unroll
            for (int j = 0; j < 8; ++j) { const f32x4 s4 = *((const f32x4*)sc + F.lane + 64 * j), h4 = *((const f32x4*)sh + F.lane + 64 * j);
                const f32x4 y = (v[j] * rstd) * (s4 + 1.0f) + h4;
                if (fp8out) o4[64 * j] = pk4f8(y.x, y.y, y.z, y.w);
                else { v2u w; w.x = pk2(y.x, y.y); w.y = pk2(y.z, y.w); o8[64 * j] = w; } }
        }
#pragma unroll
        for (int j = 0; j < 8; ++j) v[j] = vn[j];
    }
}
__device__ __forceinline__ void norm_ctx_phase(Frame& F, int layer, int which, bool ctx_from_input, bool fp8out) {
    REFRESH(F);
    const float* sh = F_MOD + (size_t)(layer * 3 + 2) * NMODW + (which ? 3 : 0) * DM; const float* sc = sh + DM;
    const int q = F.wave & 3, rsel = F.wave >> 2, nslab = which ? 4 : 11;
    volatile LAS float* red = (volatile LAS float*)F.lds;
    for (int i0 = 2 * (int)blockIdx.x; i0 < NBATCH * CTXL; i0 += 2 * F.G) {
        const int i = i0 + rsel; const int b = i / CTXL, r = i % CTXL; const size_t u = (size_t)b * ROWS_B + SEQ + r;
        const GAS f32x4* xr = (const GAS f32x4*)(ctx_from_input ? F_ctx + (size_t)i * DM : F_X + u * DM) + q * 128 + F.lane;
        f32x4 v0 = xr[0], v1 = xr[64], t[11][2];
#pragma unroll
        for (int k = 0; k < 11; ++k) { const int kk = (k < nslab) ? k : 0; const GAS f32x4* sp = (const GAS f32x4*)(F_SLAB + ((size_t)kk * 512 + i) * DM) + q * 128 + F.lane; t[k][0] = sp[0]; t[k][1] = sp[64]; }
#pragma unroll
        for (int k = 0; k < 11; ++k) if (k < nslab) { v0 += t[k][0]; v1 += t[k][1]; }
        GAS f32x4* xw = (GAS f32x4*)(F_X + u * DM) + q * 128 + F.lane; xw[0] = v0; xw[64] = v1;
        float ss = (v0.x * v0.x + v0.y * v0.y) + (v0.z * v0.z + v0.w * v0.w) + (v1.x * v1.x + v1.y * v1.y) + (v1.z * v1.z + v1.w * v1.w);
        ss = wave_sum(ss);
        __syncthreads();
        if (F.lane == 0) red[F.wave] = ss;
        __syncthreads();
        const float tot = (red[rsel * 4 + 0] + red[rsel * 4 + 1]) + (red[rsel * 4 + 2] + red[rsel * 4 + 3]);
        const float rstd = 1.0f / sqrtf(tot * (1.f / DM) + EPS);
        const f32x4 s0 = *((const f32x4*)sc + q * 128 + F.lane), s1 = *((const f32x4*)sc + q * 128 + F.lane + 64), h0 = *((const f32x4*)sh + q * 128 + F.lane), h1 = *((const f32x4*)sh + q * 128 + F.lane + 64);
        const f32x4 y0 = (v0 * rstd) * (s0 + 1.0f) + h0, y1 = (v1 * rstd) * (s1 + 1.0f) + h1;
        if (fp8out) { GAS unsigned* o4 = (GAS unsigned*)((unsigned char*)F_H + u * DM) + q * 128 + F.lane; o4[0] = pk4f8(y0.x, y0.y, y0.z, y0.w); o4[64] = pk4f8(y1.x, y1.y, y1.z, y1.w); }
        else { GAS v2u* o8 = (GAS v2u*)(F_H + u * DM) + q * 128 + F.lane; v2u w0, w1; w0.x = pk2(y0.x, y0.y); w0.y = pk2(y0.z, y0.w); w1.x = pk2(y1.x, y1.y); w1.y = pk2(y1.z, y1.w); o8[0] = w0; o8[64] = w1; }
    }
    __syncthreads();
}
__device__ __forceinline__ void final_phase(Frame& F) {
    REFRESH(F);
    const int gw = F.vcu * NWAVES + F.wave, NGW = F.G * NWAVES;
    for (int m = gw; m < NBATCH * SEQ; m += NGW) {
        const int b = m / SEQ, t = m % SEQ; const size_t u = (size_t)b * ROWS_B + t;
        const GAS f32x4* xr = (const GAS f32x4*)(F_X + u * DM) + F.lane;
        f32x4 v[8]; float ss = 0.f;
#pragma unroll
        for (int j = 0; j < 8; ++j) { v[j] = xr[64 * j]; ss += (v[j].x * v[j].x + v[j].y * v[j].y) + (v[j].z * v[j].z + v[j].w * v[j].w); }
        const float rstd = 1.0f / sqrtf(wave_sum(ss) * (1.f / DM) + EPS);
        GAS f32x4* o = (GAS f32x4*)(F_out + (size_t)m * DM) + F.lane;
#pragma unroll
        for (int j = 0; j < 8; ++j) { const f32x4 g4 = *((const f32x4*)F_fgain + F.lane + 64 * j); o[64 * j] = (v[j] * rstd) * g4; }
    }
}
__device__ __forceinline__ bool seq_first(int u) { const int w = u % ROWS_B; return w == 0 || w == SEQ; }
__device__ __forceinline__ bool seq_last(int u) { const int w = u % ROWS_B; return w == SEQ - 1 || w == ROWS_B - 1; }
__device__ __forceinline__ void ffn_fix_phase(Frame& F, int layer, bool skip_ctx) {
    REFRESH(F);
    const int gw = F.vcu * NWAVES + F.wave, NGW = F.G * NWAVES;
    constexpr int NCC = DFF / 512;
    const float* cw = F_fconv + (size_t)layer * 3 * UPW;
    for (int it = gw; it < NPAN * 2 * NCC; it += NGW) {
        const int cc = it % NCC, pe = it / NCC, edge = pe & 1, pm = pe >> 1;
        if ((pm % PAN_B) == 32) continue;
        const int row = pm * 256 + (edge ? 255 : 0), c0 = cc * 512 + F.lane * 8, yc = (c0 >> 7) * 256 + (c0 & 127);
        const float* ya; const float* yb; const float* yc_; bool za = false, zc = false;
        if (edge == 0) { za = seq_first(row); ya = F_YE + (size_t)((pm - 1) * 4 + 3) * UPW; yb = F_YE + (size_t)(pm * 4 + 0) * UPW; yc_ = F_YE + (size_t)(pm * 4 + 1) * UPW; }
        else { zc = seq_last(row); ya = F_YE + (size_t)(pm * 4 + 2) * UPW; yb = F_YE + (size_t)(pm * 4 + 3) * UPW; yc_ = F_YE + (size_t)((pm + 1) * 4 + 0) * UPW; }
        v4u o;
#pragma unroll
        for (int h = 0; h < 2; ++h) { f32x4 r[2];
#pragma unroll
            for (int bj = 0; bj < 2; ++bj) { const int yo = yc + bj * 128 + 4 * h;
                const f32x4 a = za ? (f32x4){0.f, 0.f, 0.f, 0.f} : *(const f32x4*)(ya + yo), b = *(const f32x4*)(yb + yo), c = zc ? (f32x4){0.f, 0.f, 0.f, 0.f} : *(const f32x4*)(yc_ + yo);
                const float* wp = cw + bj * DFF + c0 + 4 * h;
                r[bj] = *(const f32x4*)(wp) * a + *(const f32x4*)(wp + UPW) * b + *(const f32x4*)(wp + 2 * UPW) * c; }
            float t[4];
#pragma unroll
            for (int e = 0; e < 4; ++e) { const float g = r[0][e]; t[e] = g / (1.f + __expf(-g)) * r[1][e]; }
            o[2 * h] = pk2(t[0], t[1]); o[2 * h + 1] = pk2(t[2], t[3]); }
        *(GAS v4u*)(F_ACT + (size_t)row * DFF + c0) = o;
    }
    if (!skip_ctx) {
        const float* Y0 = F_YS; const float* Y1 = F_YS + (size_t)512 * UPW;
        for (int it = gw; it < 128 * NCC; it += NGW) {
            const int cc = it % NCC, sg = it / NCC, cr0 = sg * 4, r0 = cr0 & 255;
            const int c0 = cc * 512 + F.lane * 8, yc = (c0 >> 7) * 256 + (c0 & 127);
            f32x4 wv[3][2][2];
#pragma unroll
            for (int j = 0; j < 3; ++j)
#pragma unroll
                for (int bj = 0; bj < 2; ++bj)
#pragma unroll
                    for (int h = 0; h < 2; ++h) wv[j][bj][h] = *(const f32x4*)(cw + (size_t)j * UPW + bj * DFF + c0 + 4 * h);
            f32x4 ya[2][2], yb[2][2], yn[2][2];
#define LDROW(dst, cr_) do { const size_t o_ = (size_t)(cr_) * UPW + yc; \
                _Pragma("unroll") for (int bj = 0; bj < 2; ++bj) _Pragma("unroll") for (int h = 0; h < 2; ++h) dst[bj][h] = *(const f32x4*)(Y0 + o_ + bj * 128 + 4 * h) + *(const f32x4*)(Y1 + o_ + bj * 128 + 4 * h); } while (0)
#pragma unroll
            for (int bj = 0; bj < 2; ++bj)
#pragma unroll
                for (int h = 0; h < 2; ++h) ya[bj][h] = (f32x4){0.f, 0.f, 0.f, 0.f};
            if (r0 > 0) LDROW(ya, cr0 - 1);
            LDROW(yb, cr0);
#pragma unroll 1
            for (int k = 0; k < 4; ++k) { const int r = r0 + k;
#pragma unroll
                for (int bj = 0; bj < 2; ++bj)
#pragma unroll
                    for (int h = 0; h < 2; ++h) yn[bj][h] = (f32x4){0.f, 0.f, 0.f, 0.f};
                if (r < 255) LDROW(yn, cr0 + k + 1);
                v4u o;
#pragma unroll
                for (int h = 0; h < 2; ++h) { const f32x4 g4 = wv[0][0][h] * ya[0][h] + wv[1][0][h] * yb[0][h] + wv[2][0][h] * yn[0][h], v4 = wv[0][1][h] * ya[1][h] + wv[1][1][h] * yb[1][h] + wv[2][1][h] * yn[1][h];
                    float t[4];
#pragma unroll
                    for (int e = 0; e < 4; ++e) t[e] = g4[e] / (1.f + __expf(-g4[e])) * v4[e];
                    o[2 * h] = pk2(t[0], t[1]); o[2 * h + 1] = pk2(t[2], t[3]); }
                *(GAS v4u*)(F_ACT + ((size_t)((cr0 + k) >> 8) * ROWS_B + SEQ + r) * DFF + c0) = o;
#pragma unroll
                for (int bj = 0; bj < 2; ++bj)
#pragma unroll
                    for (int h = 0; h < 2; ++h) { ya[bj][h] = yb[bj][h]; yb[bj][h] = yn[bj][h]; } }
#undef LDROW
        }
    }
}
__device__ __forceinline__ void sconv_gate_phase(Frame& F, int j, bool skip_ctx) {
    REFRESH(F);
    const int gw = F.vcu * NWAVES + F.wave, NGW = F.G * NWAVES;
    constexpr int NCC = DM / 512, NRC = R / 8;
    const float* cw = F_sconv + (size_t)j * 3 * DM;
    for (int it = gw; it < NRC * NCC; it += NGW) {
        const int cc = it % NCC, rc = it / NCC, u0 = rc * 8, c0 = cc * 512 + F.lane * 8;
        const int pm = u0 >> 8; if (skip_ctx && (pm % PAN_B) == 32) continue;
        v4u gb[8], cz[8];
#pragma unroll
        for (int q = 0; q < 8; ++q) { gb[q] = *(const GAS v4u*)(F_GB + (size_t)(u0 + q) * DM + c0); cz[q] = *(const GAS v4u*)(F_CZ + (size_t)(u0 + q) * DM + c0); }
        const int rin = u0 & 255;
        const bool e0 = (rin == 0), e1 = (rin == 248);
        float fx[8];
        if (e0 || e1) {
            const int row = e0 ? u0 : u0 + 7; const bool za = e0 && seq_first(row), zc = e1 && seq_last(row);
            const float* ya = e0 ? F_PE + (size_t)((pm - 1) * 4 + 3) * DM : F_PE + (size_t)(pm * 4 + 2) * DM;
            const float* yb = e0 ? F_PE + (size_t)(pm * 4 + 0) * DM : F_PE + (size_t)(pm * 4 + 3) * DM;
            const float* yc = e0 ? F_PE + (size_t)(pm * 4 + 1) * DM : F_PE + (size_t)((pm + 1) * 4 + 0) * DM;
#pragma unroll
            for (int h = 0; h < 2; ++h) { const int o = c0 + 4 * h;
                const f32x4 a = za ? (f32x4){0.f, 0.f, 0.f, 0.f} : *(const f32x4*)(ya + o), b = *(const f32x4*)(yb + o), c = zc ? (f32x4){0.f, 0.f, 0.f, 0.f} : *(const f32x4*)(yc + o);
                const f32x4 r = *(const f32x4*)(cw + o) * a + *(const f32x4*)(cw + DM + o) * b + *(const f32x4*)(cw + 2 * DM + o) * c;
                fx[4 * h] = r[0]; fx[4 * h + 1] = r[1]; fx[4 * h + 2] = r[2]; fx[4 * h + 3] = r[3]; } }
#pragma unroll
        for (int q = 0; q < 8; ++q) { v4u o; const bool edge = (q == 0 && e0) || (q == 7 && e1);
#pragma unroll
            for (int e = 0; e < 4; ++e) { const float ca = edge ? fx[2 * e] : bf_lo(cz[q][e]), cb2 = edge ? fx[2 * e + 1] : bf_hi(cz[q][e]);
                o[e] = pk2(bf_lo(gb[q][e]) * ca, bf_hi(gb[q][e]) * cb2); }
            *(GAS v4u*)(F_H + (size_t)(u0 + q) * DM + c0) = o; }
    }
}
__device__ __forceinline__ void attn_phase(Frame& F, bool with_ctx, int a, float lam_init, char* lds) {
    REFRESH(F);
    const int c = blockIdx.x; const int G = F.G;
    float d1 = 0.f, d2 = 0.f;
#pragma unroll
    for (int j = 0; j < 2; ++j) { const int e = F.lane + 64 * j; d1 += F_lq1[a * 128 + e] * F_lk1[a * 128 + e]; d2 += F_lq2[a * 128 + e] * F_lk2[a * 128 + e]; }
    d1 = wave_sum(d1); d2 = wave_sum(d2);
    const float lam = expf(d1) - expf(d2) + lam_init;
    const float* gain = F_subln + a * 256;
    const int nlat = 16 * 32, ntot = nlat + (with_ctx ? 16 : 0);
    for (int L = c; L < ntot; L += G) {
        int combo, qb, kstart, seq;
        if (L < nlat) { const int rnd = L / 256, idx = L % 256; combo = rnd * 8 + (idx & 7); qb = idx >> 3; kstart = 0; seq = ROWS_B; }
        else { combo = L - nlat; qb = 32; kstart = SEQ; seq = CTXL; }
        const int h = combo & 7, b = combo >> 3;
        const size_t rowq = (size_t)b * ROWS_B + (size_t)qb * 256; const int jstart = kstart >> 6;
        const unsigned char* Vh = (const unsigned char*)F_VT + ((size_t)(b * 8 + h) * 132 + jstart) * 16384;
        float* O1 = F_OP + (size_t)((b * 8 + h) * 33 + qb) * 65536;
        unsigned short* AO = (unsigned short*)F_H + rowq * DM + h * 256;
#pragma unroll 1
        for (int i = 0; i < 2; ++i) { const int hs = 2 * h + i;
            att::attn_unit_v256((const unsigned char*)F_QKV + rowq * DM + hs * 128, (const unsigned char*)F_KT + ((size_t)(b * 16 + hs) * 132 + jstart) * 8192, Vh, O1, seq, lds, i, O1, AO, lam, gain, 1.0f - lam_init, F.wid0); }
    }
}

constexpr int PH_PER_LAYER = 9, NPHASES = 1 + DEPTH * PH_PER_LAYER + 1;
__global__ void __launch_bounds__(NWAVES * 64, 2) trunk_fwd(Args args) {
    extern __shared__ __attribute__((aligned(16))) unsigned char lds[];
    Frame F;
    F.lds = (LAS unsigned char*)lds;
    F.wid0 = __builtin_amdgcn_readfirstlane((int)threadIdx.x >> 6);
    REFRESH(F);
    F.G = gridDim.x; { const int bx = blockIdx.x; F.vcu = (F.G % 8 == 0) ? (bx % 8) * (F.G / 8) + bx / 8 : bx; }
    unsigned char* ws = args.ws; F.ws = ws; F.a = &args;
    volatile LAS unsigned* MISC = (volatile LAS unsigned*)(F.lds + MISC_OFF);
    for (int u = F.tid; u < (LDS_BYTES - MISC_OFF) / 4; u += NWAVES * 64) MISC[u] = 0u;
    __syncthreads();
    const int lo = args.ph_lo, hi = args.ph_hi; (void)lo; (void)hi;
#if MK_PER_PHASE
    XcdBarrier bar; bar.bar = nullptr; bar.x = 0; bar.st = nullptr;
#define GRID_BAR() do { } while (0)
#else
    XcdBarrier bar = xcd_barrier_post((unsigned*)(ws + WS_CTL) + CW_BAR, MISC + 8);
#define GRID_BAR() xcd_barrier(bar)
#endif
#if MK_PER_PHASE
#define IN(k) (lo <= (k) && (k) < hi)
#else
#define IN(k) true
#endif
#define SEAM(k) do { if (IN(k) && IN((k) + 1)) GRID_BAR(); } while (0)

    if (IN(0)) { p0_prologue(F); }
    SEAM(0);

#pragma unroll 1
    for (int layer = 0; layer < DEPTH; ++layer) {
        const int pb = 1 + layer * PH_PER_LAYER;
        const bool ctx_update = layer < 2;
        const bool lat_only = !ctx_update;
        const int nMl = lat_only ? 64 : NPAN;
        if ((layer & 1) == 0) {
            const int a = layer >> 1;
            const float lam_init = (layer == 0) ? 0.2f : 0.4707130183435842f;
            if (layer == 0) norm_mod_phase(F, layer, 0, false, true, 0, false, true);
            else norm_ctx_phase(F, layer, 0, false, true);
            SEAM(pb + 0);
            if (IN(pb + 1)) { pg8::Gemm g{F_H, (const pg8::bf16_t*)((const unsigned char*)F_WQKV + (size_t)a * 8192 * DM), DM}; pg8::QkvOrder S{F.G, (int)blockIdx.x};
                pg8::EpiQKV E{(unsigned char*)F_QKV, F_ROPE, (unsigned char*)F_KT, (unsigned char*)F_VT, F.wid0};
                pg8::gemm_phase<pg8::EpiQKV, pg8::QkvOrder, true, true, true>(F.lds, g, S, E, F.wid0); }
            SEAM(pb + 1);

#ifndef NO_ATTN
            if (IN(pb + 2)) { attn_phase(F, ctx_update, a, lam_init, (char*)lds); __syncthreads(); }
#endif
            SEAM(pb + 2);
            if (IN(pb + 4)) { pg8::Gemm g{F_H, F_WO + (size_t)a * DM * DM, DM}; pg8::PanelOrder S; S.init(64, DM / 256, F.G, (int)blockIdx.x, 1, DM / 64, ctx_update ? 4 : 0);
                pg8::EpiResidualNorm E{F_X, F_MOD + (size_t)(layer * 3) * NMODW + 2 * DM, (layer == 0) ? F_x : nullptr, F_SLAB, (const float*)(F.ws + WS_CTL + 32768), F_MOD + (size_t)(layer * 3) * NMODW + 3 * DM, (void*)F_H, F_XST, (unsigned*)(F.ws + WS_CTL + 40960),
                    64u * (unsigned)(2 * layer + 1), (PG8_LAS float*)(F.lds + RING_BYTES), F.wid0, 1};
                pg8::gemm_phase<pg8::EpiResidualNorm, pg8::PanelOrder, true, true>(F.lds, g, S, E, F.wid0); }
            SEAM(pb + 4);
        } else {
            const int j = layer >> 1;
            if (layer == 1) { norm_ctx_phase(F, layer, 0, false, false); SEAM(pb + 0); }
            if (IN(pb + 1)) { pg8::Gemm g{F_H, F_WIN + (size_t)j * QKVW * DM, DM}; pg8::PanelOrder S; S.init(64, QKVW / 256, F.G, (int)blockIdx.x, 1, DM / 64, ctx_update ? 1 : 0);
                pg8::EpiSconv E{F_GB, F_CZ, F_PE, F_sconv + (size_t)j * 3 * DM, (PG8_LAS float*)(F.lds + RING_BYTES)};
                pg8::gemm_phase<pg8::EpiSconv, pg8::PanelOrder, true, true>(F.lds, g, S, E, F.wid0); }
            SEAM(pb + 1);
            if (IN(pb + 2)) sconv_gate_phase(F, j, lat_only);
            SEAM(pb + 2);
            if (IN(pb + 4)) { pg8::Gemm g{F_H, F_WOUT + (size_t)j * DM * DM, DM}; pg8::PanelOrder S; S.init(64, DM / 256, F.G, (int)blockIdx.x, 1, DM / 64, ctx_update ? 4 : 0);
                pg8::EpiResidualNorm E{F_X, F_MOD + (size_t)(layer * 3) * NMODW + 2 * DM, nullptr, F_SLAB, (const float*)(F.ws + WS_CTL + 32768), F_MOD + (size_t)(layer * 3) * NMODW + 3 * DM, (void*)F_H, F_XST, (unsigned*)(F.ws + WS_CTL + 40960),
                    64u * (unsigned)(2 * layer + 1), (PG8_LAS float*)(F.lds + RING_BYTES), F.wid0, 1};
                pg8::gemm_phase<pg8::EpiResidualNorm, pg8::PanelOrder, true, true>(F.lds, g, S, E, F.wid0); }
            SEAM(pb + 4);
        }
        if (ctx_update) { norm_ctx_phase(F, layer, 1, layer == 0, false); SEAM(pb + 5); }
        if (IN(pb + 6)) { pg8::Gemm g{F_H, F_WUP + (size_t)layer * UPW * DM, DM}; pg8::PanelOrder S; S.init(64, UPW / 256, F.G, (int)blockIdx.x, 1, DM / 64, ctx_update ? 2 : 0);
            pg8::EpiConvGate E{F_ACT, F_YE, F_fconv + (size_t)layer * 3 * UPW, (PG8_LAS float*)(F.lds + RING_BYTES), ctx_update ? F_YS : nullptr};
            pg8::gemm_phase<pg8::EpiConvGate, pg8::PanelOrder, true, true>(F.lds, g, S, E, F.wid0); }
        SEAM(pb + 6);
        if (IN(pb + 7)) ffn_fix_phase(F, layer, lat_only);
        SEAM(pb + 7);
        if (IN(pb + 8)) { pg8::Gemm g{F_ACT, F_WDN + (size_t)layer * DM * DFF, DFF}; pg8::PanelOrder S; S.init(64, DM / 256, F.G, (int)blockIdx.x, 1, DFF / 64, ctx_update ? 11 : 0);
            const bool fin = (layer == DEPTH - 1);
            pg8::EpiResidualNorm E{F_X, F_MOD + (size_t)(layer * 3) * NMODW + 5 * DM, nullptr, F_SLAB, (const float*)(F.ws + WS_CTL + 32768), fin ? F_fgain : F_MOD + (size_t)((layer + 1) * 3) * NMODW, fin ? (void*)F_out : (void*)F_H, F_XST, (unsigned*)(F.ws + WS_CTL + 40960),
                64u * (unsigned)(2 * layer + 2), (PG8_LAS float*)(F.lds + RING_BYTES), F.wid0, fin ? 2 : ((layer & 1) ? 4 : 1)};
            pg8::gemm_phase<pg8::EpiResidualNorm, pg8::PanelOrder, true, true>(F.lds, g, S, E, F.wid0); }
        if (layer < DEPTH - 1) SEAM(pb + 8);
    }
#undef IN
#undef SEAM
#undef GRID_BAR
}

extern "C" void kernel_launch(void* const* d_in, const int* in_sizes, int n_in, void* d_out, int out_size, void* d_ws, size_t ws_size, hipStream_t stream) {
    static int grid = 0;
    if (grid == 0) {
        if (n_in != 20 || in_sizes[0] != NBATCH * SEQ * DM || out_size != NBATCH * SEQ * DM || ws_size < WS_END) {
            fprintf(stderr, "kernel_launch: unexpected shapes: n_in %d in0 %d out %d ws %zu (need %zu)\n", n_in, n_in > 0 ? in_sizes[0] : -1, out_size, ws_size, (size_t)WS_END); grid = -1; return; }
        int dev = 0, cus = 0, per_cu = 0;
        if (hipGetDevice(&dev) != hipSuccess || hipDeviceGetAttribute(&cus, hipDeviceAttributeMultiprocessorCount, dev) != hipSuccess) { grid = -1; return; }
        if (hipFuncSetAttribute((const void*)trunk_fwd, hipFuncAttributeMaxDynamicSharedMemorySize, LDS_BYTES) != hipSuccess) { fprintf(stderr, "kernel_launch: hipFuncSetAttribute failed\n"); grid = -1; return; }
        if (hipOccupancyMaxActiveBlocksPerMultiprocessor(&per_cu, (const void*)trunk_fwd, NWAVES * 64, LDS_BYTES) != hipSuccess || per_cu < 1)
            fprintf(stderr, "kernel_launch: note: occupancy query reports %d workgroups per CU\n", per_cu);
        (void)hipGetLastError();
        grid = cus;
    }
    if (grid < 0) return;
    (void)hipMemsetAsync((char*)d_ws + WS_CTL, 0, CTL_ZERO_BYTES, stream);
    Args a{};
    for (int i = 0; i < 20; ++i) a.in[i] = (const float*)d_in[i];
    a.out = (float*)d_out; a.ws = (unsigned char*)d_ws;
#if MK_PER_PHASE
    for (int p = 0; p < NPHASES; ++p) {
        const int k = (p - 1) % PH_PER_LAYER, layer = (p - 1) / PH_PER_LAYER;
        if (p >= 1 && p < NPHASES - 1 && (layer & 1) == 1 && k == 3) continue;
        a.ph_lo = p; a.ph_hi = p + 1;
        hipLaunchKernelGGL(trunk_fwd, dim3(grid), dim3(NWAVES * 64), LDS_BYTES, stream, a);
    }
#else
    a.ph_lo = 0; a.ph_hi = NPHASES;
    hipLaunchKernelGGL(trunk_fwd, dim3(grid), dim3(NWAVES * 64), LDS_BYTES, stream, a);
#endif
    const hipError_t le = hipPeekAtLastError();
    if (le != hipSuccess) fprintf(stderr, "kernel_launch: launch failed: %s\n", hipGetErrorName(le));
}
```
